# Optimizing an MI355X kernel written in HIP

```python
import jax, jax.numpy as jnp
from jax import lax
import numpy as np

D_MODEL = 1024
BATCH = 8
SEQ = 4096
DEPTH = 2

N_MIXERS = 2
MLA_HEADS = 16
Q_LORA = 384
KV_LORA = 256
QK_NOPE = 64
QK_ROPE = 32
V_HEAD = 64
ROPE_THETA = 10000.0
Q_BLOCK = 128
MLA_IN = Q_LORA + KV_LORA + QK_ROPE
POOL_WINDOWS = (2, 4, 8, 16)
POOL_GROUPS = len(POOL_WINDOWS)
POOL_GROUP_DIM = D_MODEL // POOL_GROUPS
MOE_GROUPS = 4
EXPERTS_PER_GROUP = 8
N_EXPERTS = MOE_GROUPS * EXPERTS_PER_GROUP
MOE_TOP_K = 2
EXPERT_FF = D_MODEL // 4
DN_ALPHA = (2.0 * DEPTH) ** 0.25
DN_BETA = (8.0 * DEPTH) ** -0.25
LN_EPS = 1e-5
RMS_EPS = 1e-6
N_MLA_LAYERS = (DEPTH + N_MIXERS - 1) // N_MIXERS
N_POOL_LAYERS = DEPTH // N_MIXERS

kernel_name = 'hybrid_mla_pool_hmoe_deepnorm_adaln'


def _layer_norm(x, g, b):
    xf = x.astype(jnp.float32)
    mu = jnp.mean(xf, axis=-1, keepdims=True)
    var = jnp.mean(jnp.square(xf - mu), axis=-1, keepdims=True)
    return ((xf - mu) * lax.rsqrt(var + LN_EPS) * g + b).astype(x.dtype)


def _rms_norm(x, g):
    xf = x.astype(jnp.float32)
    return (xf * lax.rsqrt(jnp.mean(jnp.square(xf), axis=-1, keepdims=True) + RMS_EPS) * g).astype(x.dtype)


def _rope_angles(positions):
    inv = 1.0 / (ROPE_THETA ** (jnp.arange(0, QK_ROPE, 2, dtype=jnp.float32) / QK_ROPE))
    ang = positions.astype(jnp.float32)[..., None] * inv
    return jnp.cos(ang), jnp.sin(ang)


def _apply_rope(x, cos, sin):
    x1, x2 = jnp.split(x.astype(jnp.float32), 2, axis=-1)
    return jnp.concatenate([x1 * cos - x2 * sin, x1 * sin + x2 * cos], axis=-1).astype(x.dtype)


def _mla(h, positions, w_in, q_norm_g, kv_norm_g, w_uq, w_ukv, w_o):
    B, S, _ = h.shape
    z = h @ w_in
    q_lat = _rms_norm(z[..., :Q_LORA], q_norm_g)
    kv_lat = _rms_norm(z[..., Q_LORA:Q_LORA + KV_LORA], kv_norm_g)
    cos, sin = _rope_angles(positions)
    k_rope = _apply_rope(z[..., Q_LORA + KV_LORA:], cos, sin)
    q = (q_lat @ w_uq).reshape(B, S, MLA_HEADS, QK_NOPE + QK_ROPE)
    q_nope = q[..., :QK_NOPE]
    q_rope = _apply_rope(q[..., QK_NOPE:], cos[:, :, None, :], sin[:, :, None, :])
    kv = (kv_lat @ w_ukv).reshape(B, S, MLA_HEADS, QK_NOPE + V_HEAD)
    k_nope, v = kv[..., :QK_NOPE], kv[..., QK_NOPE:]
    nb = S // Q_BLOCK
    qn_b = q_nope.reshape(B, nb, Q_BLOCK, MLA_HEADS, QK_NOPE).transpose(1, 0, 2, 3, 4)
    qr_b = q_rope.reshape(B, nb, Q_BLOCK, MLA_HEADS, QK_ROPE).transpose(1, 0, 2, 3, 4)
    starts = jnp.arange(nb, dtype=jnp.int32) * Q_BLOCK
    key_pos = jnp.arange(S, dtype=jnp.int32)
    scale = (QK_NOPE + QK_ROPE) ** -0.5

    def block(args):
        qn, qr, start = args
        s = jnp.einsum('bqhd,bkhd->bhqk', qn, k_nope) + jnp.einsum('bqhr,bkr->bhqk', qr, k_rope)
        s = s.astype(jnp.float32) * scale
        q_pos = start + jnp.arange(Q_BLOCK, dtype=jnp.int32)
        s = jnp.where(key_pos[None, :] <= q_pos[:, None], s, -jnp.inf)
        p = jax.nn.softmax(s, axis=-1).astype(v.dtype)
        return jnp.einsum('bhqk,bkhd->bqhd', p, v)

    o = lax.map(block, (qn_b, qr_b, starts))
    o = o.transpose(1, 0, 2, 3, 4).reshape(B, S, MLA_HEADS * V_HEAD)
    return o @ w_o


def _pool_mixer(h, w_pool, pool_scale):
    B, S, D = h.shape
    hf = h.astype(jnp.float32)
    cs = jnp.cumsum(hf, axis=1)
    count = jnp.arange(1, S + 1, dtype=jnp.float32)[None, :, None]
    outs = []
    for gi, w in enumerate(POOL_WINDOWS):
        sl = slice(gi * POOL_GROUP_DIM, (gi + 1) * POOL_GROUP_DIM)
        cg = cs[..., sl]
        shifted = jnp.pad(cg, ((0, 0), (w, 0), (0, 0)))[:, :S]
        mean = (cg - shifted) / jnp.minimum(count, w)
        outs.append(mean - hf[..., sl])
    mixed = jnp.stack(outs, axis=2).astype(h.dtype)
    y = jnp.einsum('bsgc,gcd->bsgd', mixed, w_pool).reshape(B, S, D)
    return y * pool_scale


def _hier_moe(h, w_gr, b_gr, w_er, b_er, w_gate, w_up, w_down):
    B, S, D = h.shape
    N = B * S
    t = h.reshape(N, D)
    g_prob = jax.nn.softmax((t @ w_gr + b_gr).astype(jnp.float32), axis=-1)
    g_p, g_idx = lax.top_k(g_prob, 1)
    e_logits = (t @ w_er + b_er).astype(jnp.float32).reshape(N, MOE_GROUPS, EXPERTS_PER_GROUP)
    sel = jnp.broadcast_to(g_idx[:, :, None], (N, 1, EXPERTS_PER_GROUP))
    e_in_group = jnp.take_along_axis(e_logits, sel, axis=1)[:, 0]
    e_top, e_idx = lax.top_k(e_in_group, MOE_TOP_K)
    e_w = jax.nn.softmax(e_top, axis=-1) * g_p
    expert_id = g_idx * EXPERTS_PER_GROUP + e_idx
    gates = jnp.sum(jax.nn.one_hot(expert_id, N_EXPERTS, dtype=jnp.float32) * e_w[..., None], axis=1)
    out = jnp.zeros((N, D), jnp.float32)
    for e in range(N_EXPERTS):
        he = jax.nn.silu(t @ w_gate[e]) * (t @ w_up[e])
        out = out + gates[:, e:e + 1] * (he @ w_down[e]).astype(jnp.float32)
    return out.astype(h.dtype).reshape(B, S, D)


def setup_inputs(seed: int = 0) -> dict:
    key = jax.random.key(seed)
    ks = jax.random.split(key, 24)
    f32 = jnp.float32

    def nrm(k, shape, scale):
        return jax.random.normal(k, shape, f32) * scale

    offsets = jax.random.randint(ks[2], (BATCH, 1), 0, 1024, dtype=jnp.int32)
    positions = (offsets + jnp.arange(SEQ, dtype=jnp.int32)[None, :]).astype(jnp.int32)
    return {
        'x': nrm(ks[0], (BATCH, SEQ, D_MODEL), 1.0),
        'c': nrm(ks[1], (BATCH, D_MODEL), 1.0),
        'positions': positions,
        'w_mod': nrm(ks[3], (DEPTH, D_MODEL, 6 * D_MODEL), 0.5 * D_MODEL ** -0.5),
        'b_mod': nrm(ks[4], (DEPTH, 6 * D_MODEL), 0.01),
        'ln_g': 1.0 + nrm(ks[5], (DEPTH, 2, D_MODEL), 0.02),
        'ln_b': nrm(ks[6], (DEPTH, 2, D_MODEL), 0.01),
        'w_in': nrm(ks[7], (N_MLA_LAYERS, D_MODEL, MLA_IN), D_MODEL ** -0.5),
        'q_norm_g': 1.0 + nrm(ks[8], (N_MLA_LAYERS, Q_LORA), 0.02),
        'kv_norm_g': 1.0 + nrm(ks[9], (N_MLA_LAYERS, KV_LORA), 0.02),
        'w_uq': nrm(ks[10], (N_MLA_LAYERS, Q_LORA, MLA_HEADS * (QK_NOPE + QK_ROPE)), Q_LORA ** -0.5),
        'w_ukv': nrm(ks[11], (N_MLA_LAYERS, KV_LORA, MLA_HEADS * (QK_NOPE + V_HEAD)), KV_LORA ** -0.5),
        'w_o': nrm(ks[12], (N_MLA_LAYERS, MLA_HEADS * V_HEAD, D_MODEL), DN_BETA * (MLA_HEADS * V_HEAD) ** -0.5),
        'w_pool': nrm(ks[13], (N_POOL_LAYERS, POOL_GROUPS, POOL_GROUP_DIM, POOL_GROUP_DIM), DN_BETA * POOL_GROUP_DIM ** -0.5),
        'pool_scale': 1.0 + nrm(ks[14], (N_POOL_LAYERS, D_MODEL), 0.1),
        'w_group_router': nrm(ks[15], (DEPTH, D_MODEL, MOE_GROUPS), D_MODEL ** -0.5),
        'b_group_router': nrm(ks[16], (DEPTH, MOE_GROUPS), 0.01),
        'w_expert_router': nrm(ks[17], (DEPTH, D_MODEL, N_EXPERTS), D_MODEL ** -0.5),
        'b_expert_router': nrm(ks[18], (DEPTH, N_EXPERTS), 0.01),
        'w_gate': nrm(ks[19], (DEPTH, N_EXPERTS, D_MODEL, EXPERT_FF), D_MODEL ** -0.5),
        'w_up': nrm(ks[20], (DEPTH, N_EXPERTS, D_MODEL, EXPERT_FF), D_MODEL ** -0.5),
        'w_down': nrm(ks[21], (DEPTH, N_EXPERTS, EXPERT_FF, D_MODEL), DN_BETA * EXPERT_FF ** -0.5),
    }


def reference(x, c, positions, w_mod, b_mod, ln_g, ln_b, w_in, q_norm_g, kv_norm_g, w_uq, w_ukv, w_o,
              w_pool, pool_scale, w_group_router, b_group_router, w_expert_router, b_expert_router,
              w_gate, w_up, w_down):
    c_act = jax.nn.silu(c)
    for i in range(DEPTH):
        mod = (c_act @ w_mod[i] + b_mod[i])[:, None, :]
        sh1, sc1, g1, sh2, sc2, g2 = jnp.split(mod, 6, axis=-1)
        j = i // N_MIXERS
        h = x * (1.0 + sc1) + sh1
        if i % N_MIXERS == 0:
            y = _mla(h, positions, w_in[j], q_norm_g[j], kv_norm_g[j], w_uq[j], w_ukv[j], w_o[j])
        else:
            y = _pool_mixer(h, w_pool[j], pool_scale[j])
        x = _layer_norm(DN_ALPHA * x + (1.0 + g1) * y, ln_g[i, 0], ln_b[i, 0])
        h = x * (1.0 + sc2) + sh2
        y = _hier_moe(h, w_group_router[i], b_group_router[i], w_expert_router[i], b_expert_router[i],
                      w_gate[i], w_up[i], w_down[i])
        x = _layer_norm(DN_ALPHA * x + (1.0 + g2) * y, ln_g[i, 1], ln_b[i, 1])
    return x
```

```cpp
#define MK_FASTMASK 0x1FFFF
#define MK_ONE_LAUNCH 1
#define MK_YF8 1
#include <hip/hip_runtime.h>
#include <cstdio>
#include <cstdint>

constexpr int BATCH = 8, SEQ = 4096, DM = 1024, M = BATCH * SEQ;
constexpr int NH = 16, QLR = 384, KVLR = 256, DNOPE = 64, DROPE = 32, DV = 64, DQK = 96, ZW = 672, ZP = 768;
constexpr int NQ = NH * DQK  , NKV = NH * (DNOPE + DV)  ;
constexpr int QP = NQ + 64, KVP = NKV + 64;
constexpr int NGRP = 4, EPG = 8, NE = 32, FF = 256, NRT = 36;
constexpr float DN_ALPHA = 1.4142135623730951f, LN_EPS = 1e-5f, RMS_EPS = 1e-6f;
constexpr float QSCALE = 0.14724444602590306f;

constexpr size_t MiB = 1u << 20;
constexpr size_t WS_CTL = 0, CTL_ZERO_BYTES = 32768;
constexpr size_t WS_MODV = 1 * MiB;
constexpr size_t WS_WGU = 2 * MiB;
constexpr size_t WS_WD = 66 * MiB;
constexpr size_t WS_WIN = 98 * MiB;
constexpr size_t WS_WUQ = WS_WIN + 1536 * 1024;
constexpr size_t WS_WUKV = WS_WUQ + 1152 * 1024;
constexpr size_t WS_WO = WS_WUKV + 1 * MiB;
constexpr size_t WS_WPOOL = WS_WO + 2 * MiB;
constexpr size_t WS_TOK = 104 * MiB + 256 * 1024;
constexpr size_t WS_RSTD = 105 * MiB;
constexpr size_t WS_X1 = 106 * MiB;
constexpr size_t WS_H2 = 170 * MiB;
constexpr size_t WS_KVB = 106 * MiB;
constexpr size_t WS_Q = 238 * MiB;
constexpr size_t WS_HE = 234 * MiB;
constexpr size_t WS_X2 = 274 * MiB;
constexpr size_t WS_O = 338 * MiB;
constexpr size_t WS_Y2 = 340 * MiB;
constexpr size_t WS_Z = 394 * MiB;
constexpr size_t WS_Y = 402 * MiB;
constexpr size_t WS_H0 = 442 * MiB;
constexpr size_t WS_CS = 300 * MiB;
constexpr size_t WS_KR = 506 * MiB;
constexpr size_t WS_LIST = 508 * MiB;
constexpr size_t WS_SSQ = 508 * MiB;
constexpr size_t WS_END = 512 * MiB;
constexpr int CW_QA = 512, CW_QB = 576;
constexpr int CW_CNT = 1024;

typedef unsigned short bf16_t;
typedef float f32x4 __attribute__((ext_vector_type(4)));
typedef float f32x2 __attribute__((ext_vector_type(2)));
typedef unsigned pg8_u32x2 __attribute__((ext_vector_type(2)));
typedef unsigned pg8_u32x4 __attribute__((ext_vector_type(4)));
#define LAS __attribute__((address_space(3)))

__device__ __forceinline__ float bf2f(bf16_t v) { return __uint_as_float((unsigned)v << 16); }
__device__ __forceinline__ unsigned cvt_pk_bf16(float lo, float hi) { unsigned r; asm volatile("v_cvt_pk_bf16_f32 %0, %1, %2" : "=v"(r) : "v"(lo), "v"(hi)); return r; }
__device__ __forceinline__ bf16_t f2bf(float f) { return (bf16_t)(cvt_pk_bf16(f, 0.f) & 0xffffu); }
__device__ __forceinline__ f32x4 ld_bf4(const bf16_t* p) { const uint2 u = *(const uint2*)p; return (f32x4){__uint_as_float(u.x << 16), __uint_as_float(u.x & 0xffff0000u), __uint_as_float(u.y << 16), __uint_as_float(u.y & 0xffff0000u)}; }
__device__ __forceinline__ void st_bf4(bf16_t* p, f32x4 v) { uint2 u; u.x = cvt_pk_bf16(v.x, v.y); u.y = cvt_pk_bf16(v.z, v.w); *(uint2*)p = u; }
__device__ __forceinline__ float wave_sum(float v) {
#pragma unroll
    for (int o = 1; o < 64; o <<= 1) v += __shfl_xor(v, o);
    return v;
}
__device__ __forceinline__ float hsum4(f32x4 v) { return (v.x + v.y) + (v.z + v.w); }
constexpr float F8S = 8.f, F8IS = 0.125f;
__device__ __forceinline__ unsigned pack_f8x4(float a, float b, float c, float d) { int v = __builtin_bit_cast(int, a);
    v = __builtin_amdgcn_cvt_pk_fp8_f32(a, b, v, false); v = __builtin_amdgcn_cvt_pk_fp8_f32(c, d, v, true); return (unsigned)v; }
__device__ __forceinline__ f32x4 unpack_f8x4(unsigned u) { const f32x2 lo = __builtin_amdgcn_cvt_pk_f32_fp8((int)u, false), hi = __builtin_amdgcn_cvt_pk_f32_fp8((int)u, true); return (f32x4){lo.x, lo.y, hi.x, hi.y}; }
__device__ __forceinline__ f32x4 ld_f8x4(const unsigned char* p) { return unpack_f8x4(*(const unsigned*)p) * F8IS; }

__constant__ double ROPE_INV_REV[16] = {0.15915494309189535, 0.08949940160889101, 0.050329212104487035, 0.0283021958306234, 0.015915494309189534, 0.008949940160889102, 0.005032921210448704, 0.00283021958306234,
    0.0015915494309189536, 0.0008949940160889102, 0.0005032921210448703, 0.00028302195830623395, 0.00015915494309189535, 8.949940160889102e-05, 5.0329212104487035e-05, 2.8302195830623396e-05};
__device__ __forceinline__ void rope_cs(int pos, int i, float& c, float& s) {
    double rv = (double)pos * ROPE_INV_REV[i]; rv -= __builtin_floor(rv); const float r = (float)rv;
    s = __builtin_amdgcn_sinf(r); c = __builtin_amdgcn_cosf(r);
}

struct RowCtx { int lane, wave, gw, ngw; };

__device__ __forceinline__ void rp_h0(const RowCtx& R, const float* x, const float* modv, bf16_t* H0, const int* positions = nullptr, float* CS = nullptr) {
    for (int task = R.gw; task < M / 16; task += R.ngw) {
        const int m0 = task * 16, b = m0 / SEQ; const float* mv = modv + (size_t)b * 6 * DM;
        f32x4 sh[4], sc[4];
#pragma unroll
        for (int j = 0; j < 4; ++j) { const int e = 8 * R.lane + 512 * (j >> 1) + 4 * (j & 1); sh[j] = *(const f32x4*)(mv + e); sc[j] = 1.f + *(const f32x4*)(mv + DM + e); }
#pragma unroll 1
        for (int rb = 0; rb < 16; rb += 4) {
            f32x4 v[4][4];
#pragma unroll
            for (int r = 0; r < 4; ++r)
#pragma unroll
                for (int j = 0; j < 4; ++j) v[r][j] = *(const f32x4*)(x + (size_t)(m0 + rb + r) * DM + 8 * R.lane + 512 * (j >> 1) + 4 * (j & 1));
#pragma unroll
            for (int r = 0; r < 4; ++r)
#pragma unroll
                for (int jp = 0; jp < 2; ++jp) { const f32x4 a0 = v[r][2 * jp] * sc[2 * jp] + sh[2 * jp], a1 = v[r][2 * jp + 1] * sc[2 * jp + 1] + sh[2 * jp + 1];
                    pg8_u32x4 w; w.x = cvt_pk_bf16(a0.x, a0.y); w.y = cvt_pk_bf16(a0.z, a0.w); w.z = cvt_pk_bf16(a1.x, a1.y); w.w = cvt_pk_bf16(a1.z, a1.w);
                    *(pg8_u32x4*)(H0 + (size_t)(m0 + rb + r) * DM + 8 * R.lane + 512 * jp) = w; }
            if (CS && R.lane < 16) {
#pragma unroll
                for (int r = 0; r < 4; ++r) { const int m = m0 + rb + r; float c, s; rope_cs(positions[m], R.lane, c, s); CS[(size_t)m * 32 + R.lane] = c; CS[(size_t)m * 32 + 16 + R.lane] = s; } }
        }
    }
}

__device__ __forceinline__ void rp_rms(const RowCtx& R, const bf16_t* Z, const int* positions, float* rstd, bf16_t* KR, float* CS) {
    for (int m = R.gw; m < M; m += R.ngw) {
        const bf16_t* z = Z + (size_t)m * ZP;
        float sq = 0.f, sk = 0.f;
        { const unsigned* p = (const unsigned*)(z + 6 * R.lane);
#pragma unroll
          for (int i = 0; i < 3; ++i) { const unsigned u = p[i]; const float a = __uint_as_float(u << 16), b = __uint_as_float(u & 0xffff0000u); sq += a * a + b * b; } }
        { const f32x4 v = ld_bf4(z + QLR + 4 * R.lane); sk = v.x * v.x + v.y * v.y + v.z * v.z + v.w * v.w; }
        sq = wave_sum(sq); sk = wave_sum(sk);
        if (R.lane == 0) { rstd[2 * m] = 1.f / sqrtf(sq * (1.f / QLR) + RMS_EPS); rstd[2 * m + 1] = 1.f / sqrtf(sk * (1.f / KVLR) + RMS_EPS); }
        if (R.lane < 16) { const float x1 = bf2f(z[QLR + KVLR + R.lane]), x2 = bf2f(z[QLR + KVLR + 16 + R.lane]); float c, s; rope_cs(positions[m], R.lane, c, s); CS[(size_t)m * 32 + R.lane] = c; CS[(size_t)m * 32 + 16 + R.lane] = s;
            KR[(size_t)m * 32 + R.lane] = f2bf(x1 * c - x2 * s); KR[(size_t)m * 32 + 16 + R.lane] = f2bf(x1 * s + x2 * c); }
    }
}

constexpr int LN1_LDS_WR = 0, LN1_LDS_SCR = NRT * DM * 4, LN1_LDS_HIST = LN1_LDS_SCR + 8 * 512, LN1_LDS_BYTES = LN1_LDS_HIST + 256;
template <bool RES_F32, bool TICKETS>
__device__ __forceinline__ void rp_ln1(LAS unsigned char* lds, int layer, const void* res, const bf16_t* ybr, const float* modv_l, const float* lng, const float* lnb,
                                       const float* w_gr, const float* b_gr, const float* w_er, const float* b_er, bf16_t* X1, bf16_t* H2,
                                       int* tok_e, float* tok_w, int* tok_t, unsigned* cnt, int* list) {
    const int tid = threadIdx.x, lane = tid & 63, wave = tid >> 6, nthr = blockDim.x, nwave = nthr >> 6;
    LAS float* wr = (LAS float*)(lds + LN1_LDS_WR);
    LAS float* scr = (LAS float*)(lds + LN1_LDS_SCR) + wave * 128;
    LAS unsigned* hist = (LAS unsigned*)(lds + LN1_LDS_HIST);
    for (int i = tid; i < DM * 4; i += nthr) { const int k = i >> 2, c = i & 3; wr[c * DM + k] = w_gr[(size_t)layer * DM * 4 + i]; }
    for (int i = tid; i < DM * 32; i += nthr) { const int k = i >> 5, c = i & 31; wr[(4 + c) * DM + k] = w_er[(size_t)layer * DM * 32 + i]; }
    if (tid < 64) hist[tid] = 0u;
    __syncthreads();
    const int rows_per_blk = M / gridDim.x, row0 = blockIdx.x * rows_per_blk;
    f32x4 lg4[4], lb4[4];
#pragma unroll
    for (int j = 0; j < 4; ++j) { lg4[j] = *(const f32x4*)(lng + 4 * lane + 256 * j); lb4[j] = *(const f32x4*)(lnb + 4 * lane + 256 * j); }
    for (int it = wave * 2; it < rows_per_blk; it += nwave * 2) {
        const int m0 = row0 + it; const int b = m0 / SEQ; const float* mv = modv_l + (size_t)b * 6 * DM;
        f32x4 h[2][4];
#pragma unroll
        for (int r = 0; r < 2; ++r) {
            const int m = m0 + r; f32x4 u[4]; float s = 0.f;
#pragma unroll
            for (int j = 0; j < 4; ++j) { const int e = 4 * lane + 256 * j;
                f32x4 rv; if (RES_F32) rv = *(const f32x4*)((const float*)res + (size_t)m * DM + e); else rv = ld_bf4((const bf16_t*)res + (size_t)m * DM + e);
                const f32x4 yv = ld_bf4(ybr + (size_t)m * DM + e), g1 = *(const f32x4*)(mv + 2 * DM + e);
                u[j] = DN_ALPHA * rv + (1.f + g1) * yv; s += hsum4(u[j]); }
            const float mean = wave_sum(s) * (1.f / DM); float s2 = 0.f;
#pragma unroll
            for (int j = 0; j < 4; ++j) { u[j] = u[j] - mean; s2 += hsum4(u[j] * u[j]); }
            const float rs = 1.f / sqrtf(wave_sum(s2) * (1.f / DM) + LN_EPS);
#pragma unroll
            for (int j = 0; j < 4; ++j) { const int e = 4 * lane + 256 * j;
                const f32x4 x1 = u[j] * rs * lg4[j] + lb4[j]; st_bf4(X1 + (size_t)m * DM + e, x1);
                const f32x4 sh = *(const f32x4*)(mv + 3 * DM + e), sc = *(const f32x4*)(mv + 4 * DM + e);
                h[r][j] = x1 * (1.f + sc) + sh; st_bf4(H2 + (size_t)m * DM + e, h[r][j]); }
        }
        float part[80];
#pragma unroll
        for (int c = 0; c < NRT; ++c) {
            const LAS f32x4* wp = (const LAS f32x4*)(wr + c * DM) + lane;
            const f32x4 w0 = wp[0], w1 = wp[64], w2 = wp[128], w3 = wp[192];
#pragma unroll
            for (int r = 0; r < 2; ++r) { const f32x4 sv = h[r][0] * w0 + h[r][1] * w1 + h[r][2] * w2 + h[r][3] * w3; part[r * 40 + c] = hsum4(sv); }
        }
#pragma unroll
        for (int c = NRT; c < 40; ++c) { part[c] = 0.f; part[40 + c] = 0.f; }
        { const bool up = (lane & 32) != 0;
#pragma unroll
          for (int i = 0; i < 40; ++i) { const float send = up ? part[i] : part[i + 40]; const float recv = __shfl_xor(send, 32); const float keep = up ? part[i + 40] : part[i]; part[i] = keep + recv; } }
        { const bool up = (lane & 16) != 0;
#pragma unroll
          for (int i = 0; i < 20; ++i) { const float send = up ? part[i] : part[i + 20]; const float recv = __shfl_xor(send, 16); const float keep = up ? part[i + 20] : part[i]; part[i] = keep + recv; } }
        { const bool up = (lane & 8) != 0;
#pragma unroll
          for (int i = 0; i < 10; ++i) { const float send = up ? part[i] : part[i + 10]; const float recv = __shfl_xor(send, 8); const float keep = up ? part[i + 10] : part[i]; part[i] = keep + recv; } }
        { const bool up = (lane & 4) != 0;
#pragma unroll
          for (int i = 0; i < 5; ++i) { const float send = up ? part[i] : part[i + 5]; const float recv = __shfl_xor(send, 4); const float keep = up ? part[i + 5] : part[i]; part[i] = keep + recv; } }
#pragma unroll
        for (int i = 0; i < 5; ++i) { part[i] += __shfl_xor(part[i], 2); part[i] += __shfl_xor(part[i], 1); }
        if ((lane & 3) == 0) { const int vb = 40 * ((lane >> 5) & 1) + 20 * ((lane >> 4) & 1) + 10 * ((lane >> 3) & 1) + 5 * ((lane >> 2) & 1);
#pragma unroll
            for (int i = 0; i < 5; ++i) scr[vb + i] = part[i]; }
        asm volatile("s_waitcnt lgkmcnt(0)" ::: "memory");
        if (lane < 2) {
            const int m = m0 + lane; const LAS float* lgt = scr + lane * 40;
            float gmax = lgt[0] + b_gr[layer * 4 + 0]; int gi = 0; float gl[4];
            gl[0] = gmax;
#pragma unroll
            for (int i = 1; i < 4; ++i) { gl[i] = lgt[i] + b_gr[layer * 4 + i]; if (gl[i] > gmax) { gmax = gl[i]; gi = i; } }
            float gs = 0.f;
#pragma unroll
            for (int i = 0; i < 4; ++i) gs += __expf(gl[i] - gmax);
            const float gp = 1.f / gs;
            float v1 = -INFINITY, v2 = -INFINITY; int i1 = 0, i2 = 0;
            for (int i = 0; i < 8; ++i) { const float v = lgt[4 + gi * 8 + i] + b_er[layer * 32 + gi * 8 + i];
                if (v > v1) { v2 = v1; i2 = i1; v1 = v; i1 = i; } else if (v > v2) { v2 = v; i2 = i; } }
            const float e2 = __expf(v2 - v1), w1 = gp / (1.f + e2), w2 = gp * e2 / (1.f + e2);
            const int e1i = gi * 8 + i1, e2i = gi * 8 + i2;
            tok_e[2 * m] = e1i; tok_e[2 * m + 1] = e2i; tok_w[2 * m] = w1; tok_w[2 * m + 1] = w2;
            if (TICKETS) { tok_t[2 * m] = (int)__hip_atomic_fetch_add(hist + e1i, 1u, __ATOMIC_RELAXED, __HIP_MEMORY_SCOPE_WORKGROUP); tok_t[2 * m + 1] = (int)__hip_atomic_fetch_add(hist + e2i, 1u, __ATOMIC_RELAXED, __HIP_MEMORY_SCOPE_WORKGROUP); }
        }
    }
    if (TICKETS) {
        __syncthreads();
        if (tid < 32) { const unsigned n = hist[tid]; hist[32 + tid] = n ? __hip_atomic_fetch_add(cnt + tid, n, __ATOMIC_RELAXED, __HIP_MEMORY_SCOPE_AGENT) : 0u; }
        __syncthreads();
        for (int i = tid; i < rows_per_blk * 2; i += nthr) { const int idx = row0 * 2 + i; const int e = tok_e[idx]; const int t = tok_t[idx] + (int)hist[32 + e]; tok_t[idx] = t; list[(size_t)e * M + t] = idx >> 1; }
    }
}

template <bool OUT_F32, bool SORTED, bool Y2F8 = false>
__device__ __forceinline__ void rp_ln2(const RowCtx& R, const bf16_t* X1, const bf16_t* Y2, const int* tok_e, const float* tok_w, const int* tok_t, const unsigned* cnt,
                                       const float* modv_l, const float* lng, const float* lnb, void* out) {
#define LN2_E(j) (8 * R.lane + 512 * ((j) >> 1) + 4 * ((j) & 1))
#define LN2_BF2(lo_, hi_) ((f32x4){__uint_as_float((lo_) << 16), __uint_as_float((lo_) & 0xffff0000u), __uint_as_float((hi_) << 16), __uint_as_float((hi_) & 0xffff0000u)})
    f32x4 lg4[4], lb4[4];
#pragma unroll
    for (int j = 0; j < 4; ++j) { lg4[j] = *(const f32x4*)(lng + LN2_E(j)); lb4[j] = *(const f32x4*)(lnb + LN2_E(j)); }
    int mybase = 0;
    if (SORTED) { const int c = (R.lane < 32) ? (int)cnt[R.lane] : 0; int pad = (c + 255) & ~255; int incl = pad;
#pragma unroll
        for (int o = 1; o < 32; o <<= 1) { const int t = __shfl_up(incl, o); if ((R.lane & 31) >= o) incl += t; }
        mybase = incl - pad; }
    for (int task = R.gw; task < M / 16; task += R.ngw) {
        const int m0 = task * 16, b = m0 / SEQ; const float* mv = modv_l + (size_t)b * 6 * DM;
        const int ml = m0 + (R.lane & 15);
        const int e0 = tok_e[2 * ml], e1 = tok_e[2 * ml + 1]; const float wl0 = tok_w[2 * ml], wl1 = tok_w[2 * ml + 1];
        int rl0, rl1;
        if (SORTED) { const int t0 = tok_t[2 * ml], t1 = tok_t[2 * ml + 1]; rl0 = __shfl(mybase, e0) + t0; rl1 = __shfl(mybase, e1) + t1; } else { rl0 = 2 * ml; rl1 = rl0 + 1; }
        f32x4 g2[4];
#pragma unroll
        for (int j = 0; j < 4; ++j) g2[j] = 1.f + *(const f32x4*)(mv + 5 * DM + LN2_E(j));
#pragma unroll 1
        for (int rb = 0; rb < 16; rb += 2) {
            f32x4 xv[2][4], ya[2][4], yb[2][4]; float w0[2], w1[2];
#pragma unroll
            for (int r = 0; r < 2; ++r) { const size_t r0 = (size_t)__shfl(rl0, rb + r), r1 = (size_t)__shfl(rl1, rb + r); w0[r] = __shfl(wl0, rb + r); w1[r] = __shfl(wl1, rb + r);
#pragma unroll
                for (int jp = 0; jp < 2; ++jp) { const int e = 8 * R.lane + 512 * jp;
                    const pg8_u32x4 xw = *(const pg8_u32x4*)(X1 + (size_t)(m0 + rb + r) * DM + e); xv[r][2 * jp] = LN2_BF2(xw.x, xw.y); xv[r][2 * jp + 1] = LN2_BF2(xw.z, xw.w);
                    if (Y2F8) { const pg8_u32x2 aw = *(const pg8_u32x2*)((const unsigned char*)Y2 + r0 * DM + e), bw = *(const pg8_u32x2*)((const unsigned char*)Y2 + r1 * DM + e);
                        ya[r][2 * jp] = unpack_f8x4(aw.x) * F8IS; ya[r][2 * jp + 1] = unpack_f8x4(aw.y) * F8IS; yb[r][2 * jp] = unpack_f8x4(bw.x) * F8IS; yb[r][2 * jp + 1] = unpack_f8x4(bw.y) * F8IS; }
                    else { const pg8_u32x4 aw = *(const pg8_u32x4*)(Y2 + r0 * DM + e), bw = *(const pg8_u32x4*)(Y2 + r1 * DM + e);
                        ya[r][2 * jp] = LN2_BF2(aw.x, aw.y); ya[r][2 * jp + 1] = LN2_BF2(aw.z, aw.w); yb[r][2 * jp] = LN2_BF2(bw.x, bw.y); yb[r][2 * jp + 1] = LN2_BF2(bw.z, bw.w); } } }
#pragma unroll
            for (int r = 0; r < 2; ++r) { const int m = m0 + rb + r; f32x4 u[4]; float s = 0.f;
#pragma unroll
                for (int j = 0; j < 4; ++j) { u[j] = DN_ALPHA * xv[r][j] + g2[j] * (w0[r] * ya[r][j] + w1[r] * yb[r][j]); s += hsum4(u[j]); }
                const float mean = wave_sum(s) * (1.f / DM); float s2 = 0.f;
#pragma unroll
                for (int j = 0; j < 4; ++j) { u[j] = u[j] - mean; s2 += hsum4(u[j] * u[j]); }
                const float rs = 1.f / sqrtf(wave_sum(s2) * (1.f / DM) + LN_EPS);
#pragma unroll
                for (int jp = 0; jp < 2; ++jp) { const int e = 8 * R.lane + 512 * jp; const f32x4 o0 = u[2 * jp] * rs * lg4[2 * jp] + lb4[2 * jp], o1 = u[2 * jp + 1] * rs * lg4[2 * jp + 1] + lb4[2 * jp + 1];
                    if (OUT_F32) { *(f32x4*)((float*)out + (size_t)m * DM + e) = o0; *(f32x4*)((float*)out + (size_t)m * DM + e + 4) = o1; }
                    else { pg8_u32x4 w; w.x = cvt_pk_bf16(o0.x, o0.y); w.y = cvt_pk_bf16(o0.z, o0.w); w.z = cvt_pk_bf16(o1.x, o1.y); w.w = cvt_pk_bf16(o1.z, o1.w); *(pg8_u32x4*)((bf16_t*)out + (size_t)m * DM + e) = w; } } }
        }
    }
#undef LN2_E
#undef LN2_BF2
}

__device__ __forceinline__ void rp_pool(const RowCtx& R, const bf16_t* X2, const float* modv_l, bf16_t* MIX) {
    for (int task = R.gw; task < M / 16; task += R.ngw) {
        const int m0 = task * 16, b = m0 / SEQ, t0 = m0 % SEQ; const float* mv = modv_l + (size_t)b * 6 * DM;
        f32x4 sh[4], sc[4], S[4];
#pragma unroll
        for (int j = 0; j < 4; ++j) { const int e = 4 * R.lane + 256 * j; sh[j] = *(const f32x4*)(mv + e); sc[j] = 1.f + *(const f32x4*)(mv + DM + e); S[j] = (f32x4){0.f, 0.f, 0.f, 0.f}; }
#pragma unroll
        for (int j = 0; j < 4; ++j) { const int w = 2 << j, e = 4 * R.lane + 256 * j;
            for (int i = 1; i < w; ++i) if (t0 - i >= 0) S[j] += ld_bf4(X2 + (size_t)(m0 - i) * DM + e) * sc[j] + sh[j]; }
#pragma unroll 1
        for (int rb = 0; rb < 16; rb += 4) {
            pg8_u32x2 cur[4][4], lag[4][4];
#pragma unroll
            for (int r = 0; r < 4; ++r)
#pragma unroll
                for (int j = 0; j < 4; ++j) { const int w = 2 << j, e = 4 * R.lane + 256 * j; const int m = m0 + rb + r, t = t0 + rb + r;
                    cur[r][j] = *(const pg8_u32x2*)(X2 + (size_t)m * DM + e);
                    lag[r][j] = (t - w + 1 >= 0) ? *(const pg8_u32x2*)(X2 + (size_t)(m - w + 1) * DM + e) : (pg8_u32x2){0u, 0u}; }
#pragma unroll
            for (int r = 0; r < 4; ++r) { const int m = m0 + rb + r, t = t0 + rb + r;
#pragma unroll
                for (int j = 0; j < 4; ++j) { const int w = 2 << j, e = 4 * R.lane + 256 * j;
                    const f32x4 hv = (f32x4){__uint_as_float(cur[r][j].x << 16), __uint_as_float(cur[r][j].x & 0xffff0000u), __uint_as_float(cur[r][j].y << 16), __uint_as_float(cur[r][j].y & 0xffff0000u)} * sc[j] + sh[j]; S[j] += hv;
                    const float inv = 1.f / (float)((t + 1 < w) ? (t + 1) : w);
                    st_bf4(MIX + (size_t)m * DM + e, S[j] * inv - hv);
                    if (t - w + 1 >= 0) S[j] -= (f32x4){__uint_as_float(lag[r][j].x << 16), __uint_as_float(lag[r][j].x & 0xffff0000u), __uint_as_float(lag[r][j].y << 16), __uint_as_float(lag[r][j].y & 0xffff0000u)} * sc[j] + sh[j]; }
            }
        }
    }
}

__global__ void __launch_bounds__(256) nk_mod(const float* c, const float* w_mod, const float* b_mod, float* modv) {
    const int idx = blockIdx.x * 256 + threadIdx.x; const int j = idx % 6144, b = (idx / 6144) % 8, l = idx / (6144 * 8);
    float acc = b_mod[l * 6144 + j]; const float* w = w_mod + (size_t)l * DM * 6144 + j; const float* cb = c + b * DM;
    for (int k = 0; k < DM; ++k) { const float cv = cb[k]; acc += (cv / (1.f + __expf(-cv))) * w[(size_t)k * 6144]; }
    modv[idx] = acc;
}
__global__ void __launch_bounds__(512) rk_h0(const float* x, const float* modv, bf16_t* H0) { RowCtx R{(int)threadIdx.x & 63, (int)threadIdx.x >> 6, (int)(blockIdx.x * 8 + (threadIdx.x >> 6)), (int)gridDim.x * 8}; rp_h0(R, x, modv, H0); }
__global__ void __launch_bounds__(512) rk_rms(const bf16_t* Z, const int* pos, float* rstd, bf16_t* KR, float* CS) { RowCtx R{(int)threadIdx.x & 63, (int)threadIdx.x >> 6, (int)(blockIdx.x * 8 + (threadIdx.x >> 6)), (int)gridDim.x * 8}; rp_rms(R, Z, pos, rstd, KR, CS); }
template <bool RES_F32, bool TICKETS>
__global__ void __launch_bounds__(512) rk_ln1(int layer, const void* res, const bf16_t* ybr, const float* modv_l, const float* lng, const float* lnb, const float* w_gr, const float* b_gr, const float* w_er, const float* b_er,
                                             bf16_t* X1, bf16_t* H2, int* tok_e, float* tok_w, int* tok_t, unsigned* cnt, int* list) {
    extern __shared__ __attribute__((aligned(16))) unsigned char lds_dyn[];
    rp_ln1<RES_F32, TICKETS>((LAS unsigned char*)lds_dyn, layer, res, ybr, modv_l, lng, lnb, w_gr, b_gr, w_er, b_er, X1, H2, tok_e, tok_w, tok_t, cnt, list);
}
template <bool OUT_F32, bool SORTED>
__global__ void __launch_bounds__(512) rk_ln2(const bf16_t* X1, const bf16_t* Y2, const int* tok_e, const float* tok_w, const int* tok_t, const unsigned* cnt, const float* modv_l, const float* lng, const float* lnb, void* out) {
    RowCtx R{(int)threadIdx.x & 63, (int)threadIdx.x >> 6, (int)(blockIdx.x * 8 + (threadIdx.x >> 6)), (int)gridDim.x * 8}; rp_ln2<OUT_F32, SORTED>(R, X1, Y2, tok_e, tok_w, tok_t, cnt, modv_l, lng, lnb, out);
}
__global__ void __launch_bounds__(512) rk_pool(const bf16_t* X2, const float* modv_l, bf16_t* MIX) { RowCtx R{(int)threadIdx.x & 63, (int)threadIdx.x >> 6, (int)(blockIdx.x * 8 + (threadIdx.x >> 6)), (int)gridDim.x * 8}; rp_pool(R, X2, modv_l, MIX); }

struct EpiPlain { bf16_t* O; const float* rowscale; const float* colscale; int ldo; int rs_stride; float scale; int pad;
    __device__ __forceinline__ void operator()(int m, int n, float v) const { float s = scale; if (rowscale) s *= rowscale[(size_t)m * rs_stride]; if (colscale) s *= colscale[n]; O[(size_t)m * ldo + n] = f2bf(v * s); } };
static EpiPlain mk_epi(bf16_t* O, int ldo, const float* rowscale, int rs_stride, float scale, const float* colscale) { EpiPlain e{}; e.O = O; e.rowscale = rowscale; e.colscale = colscale; e.ldo = ldo; e.rs_stride = rs_stride; e.scale = scale; e.pad = 0; return e; }
template <class Epi>
__global__ void __launch_bounds__(256) nk_gemm(const bf16_t* A, int lda, const float* W, int ldw, const float* kscale, int K, int N, Epi epi) {
    const int n = blockIdx.x * 256 + threadIdx.x, m0 = blockIdx.y * 8;
    if (n >= N) return;
    float acc[8];
#pragma unroll
    for (int r = 0; r < 8; ++r) acc[r] = 0.f;
    for (int k = 0; k < K; ++k) { float w = W[(size_t)k * ldw + n]; if (kscale) w *= kscale[k];
#pragma unroll
        for (int r = 0; r < 8; ++r) acc[r] += bf2f(A[(size_t)(m0 + r) * lda + k]) * w; }
#pragma unroll
    for (int r = 0; r < 8; ++r) epi(m0 + r, n, acc[r]);
}
__global__ void __launch_bounds__(256) nk_rope_q(bf16_t* Q, const int* positions) {
    const int idx = blockIdx.x * 256 + threadIdx.x; const int i = idx & 15, h = (idx >> 4) & 15, m = idx >> 8;
    if (m >= M) return;
    bf16_t* p = Q + (size_t)m * QP + h * DQK + DNOPE; const float x1 = bf2f(p[i]), x2 = bf2f(p[16 + i]); float c, s; rope_cs(positions[m], i, c, s);
    p[i] = f2bf(x1 * c - x2 * s); p[16 + i] = f2bf(x1 * s + x2 * c);
}
__global__ void __launch_bounds__(64) nk_attn(const bf16_t* Q, const bf16_t* KVB, const bf16_t* KR, bf16_t* O) {
    const int lane = threadIdx.x, qc = blockIdx.x, h = blockIdx.y, b = blockIdx.z;
    const int t = qc * 64 + lane; const size_t rowb = (size_t)b * SEQ;
    float q[DQK], o[DV];
    { const bf16_t* qp = Q + (rowb + t) * QP + h * DQK;
#pragma unroll
      for (int d = 0; d < DQK; d += 4) { const f32x4 v = ld_bf4(qp + d); q[d] = v.x; q[d + 1] = v.y; q[d + 2] = v.z; q[d + 3] = v.w; } }
#pragma unroll
    for (int d = 0; d < DV; ++d) o[d] = 0.f;
    float mx = -INFINITY, l = 0.f;
    const int kend = qc * 64 + 63;
    for (int k = 0; k <= kend; ++k) {
        const bf16_t* kp = KVB + (rowb + k) * KVP + h * 128; const bf16_t* rp = KR + (rowb + k) * 32;
        float s = 0.f;
#pragma unroll
        for (int d = 0; d < DNOPE; d += 4) { const f32x4 v = ld_bf4(kp + d); s += q[d] * v.x + q[d + 1] * v.y + q[d + 2] * v.z + q[d + 3] * v.w; }
#pragma unroll
        for (int d = 0; d < DROPE; d += 4) { const f32x4 v = ld_bf4(rp + d); s += q[64 + d] * v.x + q[65 + d] * v.y + q[66 + d] * v.z + q[67 + d] * v.w; }
        if (k > t) s = -INFINITY;
        const float mn = fmaxf(mx, s); const float f = exp2f(mx - mn), p = exp2f(s - mn);
        l = l * f + p; mx = mn;
#pragma unroll
        for (int d = 0; d < DV; d += 4) { const f32x4 v = ld_bf4(kp + 64 + d); o[d] = o[d] * f + p * v.x; o[d + 1] = o[d + 1] * f + p * v.y; o[d + 2] = o[d + 2] * f + p * v.z; o[d + 3] = o[d + 3] * f + p * v.w; }
    }
    const float il = 1.f / l; bf16_t* op = O + (rowb + t) * DM + h * DV;
#pragma unroll
    for (int d = 0; d < DV; d += 4) st_bf4(op + d, (f32x4){o[d] * il, o[d + 1] * il, o[d + 2] * il, o[d + 3] * il});
}
__global__ void __launch_bounds__(256) nk_moe(const bf16_t* H2, const int* tok_e, const float* wg, const float* wu, const float* wd, bf16_t* Y2) {
    __shared__ float hs[DM]; __shared__ float he[FF];
    const int p = blockIdx.x, m = p >> 1, tid = threadIdx.x; const int e = tok_e[p];
    for (int i = tid; i < DM; i += 256) hs[i] = bf2f(H2[(size_t)m * DM + i]);
    __syncthreads();
    const float* Wg = wg + (size_t)e * DM * FF + tid; const float* Wu = wu + (size_t)e * DM * FF + tid;
    float g = 0.f, u = 0.f;
    for (int k = 0; k < DM; ++k) { g += hs[k] * Wg[(size_t)k * FF]; u += hs[k] * Wu[(size_t)k * FF]; }
    he[tid] = g / (1.f + __expf(-g)) * u;
    __syncthreads();
    const float* Wd = wd + (size_t)e * FF * DM;
#pragma unroll
    for (int c = 0; c < 4; ++c) { const int col = tid + 256 * c; float a = 0.f; for (int j = 0; j < FF; ++j) a += he[j] * Wd[(size_t)j * DM + col]; Y2[(size_t)p * DM + col] = f2bf(a); }
}

namespace pg8 {
typedef short bf16x8 __attribute__((ext_vector_type(8)));
typedef unsigned u32x4 __attribute__((ext_vector_type(4)));
typedef unsigned u32x2 __attribute__((ext_vector_type(2)));
constexpr int BM = 256, BK = 64, HALF = 128, HTB = HALF * BK * 2, STAGE_BYTES = 8 * HTB, NXCD = 8, WGM = 8;
__host__ __device__ __forceinline__ int lds_byte(int r, int c) { const int st = (r >> 4) * 2 + (c >> 5), rr = r & 15, cc = c & 31, ob = rr * 64 + cc * 2; return st * 1024 + (ob ^ (((ob >> 9) & 1) << 5)); }
__host__ __device__ __forceinline__ void stage_rc(int b, int& R, int& C) { const int st = b / 1024, sb = b % 1024, swz = sb ^ (((sb >> 9) & 1) << 5); R = (st >> 1) * 16 + swz / 64; C = (st & 1) * 32 + (swz % 64) / 2; }
__host__ __device__ __forceinline__ int perm32(int rho) { const int n = rho >> 4, i = rho & 15; return 8 * (i >> 2) + 4 * n + (i & 3); }

struct Unit { int pm, pn, e, cnt, slot, pad; const char* a; const char* b; };

template <int NN>
struct StaticOrderT {
    static constexpr int nM = M / BM, nN = NN, nwg = nM * nN, nig = WGM * nN;
    static_assert(nM % WGM == 0 && nwg % NXCD == 0, "StaticOrderT: whole groups, whole XCD shares");
    int G, c; const char* A; const char* Bt; int lda, ldb;
    __device__ void init(const void* A_, int lda_, const void* Bt_, int ldb_, int, int, int G_, int c_) { A = (const char*)A_; Bt = (const char*)Bt_; lda = lda_; ldb = ldb_; G = G_; c = c_; }
    __device__ __forceinline__ bool next(int i, Unit& u) const {
        const int L = i * G + c; if (L >= nwg) return false;
        const int wgid = (L % NXCD) * (nwg / NXCD) + L / NXCD;
        const int gid = wgid / nig, rem = wgid % nig;
        u.pm = gid * WGM + (rem % WGM); u.pn = rem / WGM; u.e = 0; u.cnt = 0; u.slot = i; u.pad = 0;
        u.a = A + (size_t)u.pm * BM * lda * 2; u.b = Bt + (size_t)u.pn * BM * ldb * 2; return true;
    }
    __device__ __forceinline__ unsigned a_row_off(const Unit&, int r) const { return (unsigned)(r * lda * 2); }
};
struct BlockDiagOrder {
    int nM, G, c; const char* A; const char* Bt; int lda;
    __device__ void init(const void* A_, int lda_, const void* Bt_, int Mr, int G_, int c_) { A = (const char*)A_; Bt = (const char*)Bt_; lda = lda_; nM = Mr / BM; G = G_; c = c_; }
    __device__ __forceinline__ bool next(int i, Unit& u) const {
        const int L = i * G + c; if (L >= nM * 4) return false;
        u.pm = L >> 2; u.pn = L & 3; u.e = 0; u.cnt = 0; u.slot = 0; u.pad = 0;
        u.a = A + ((size_t)u.pm * BM * lda + 256 * u.pn) * 2; u.b = Bt + (size_t)u.pn * 256 * 256 * 2; return true;
    }
    __device__ __forceinline__ unsigned a_row_off(const Unit&, int r) const { return (unsigned)(r * lda * 2); }
};
template <int NCOL>
struct MoeOrder {
    static constexpr int ncol = NCOL;
    int G, c, gather; const LAS int* tb; const LAS int* rowtab; const unsigned* cnt; const char* A; const char* Bt; int lda; size_t bstride;
    __device__ __forceinline__ bool next(int i, Unit& u) const {
        const int L = i * G + c; const int total = tb[32]; if (L >= total * ncol) return false;
        const int rt = L / ncol; u.pn = L - rt * ncol; int e = 0;
#pragma unroll 1
        for (int j = 16; j >= 1; j >>= 1) if (tb[e + j] <= rt) e += j;
        u.pm = rt; u.e = e; u.cnt = (int)cnt[e] - (rt - tb[e]) * BM; u.slot = i; u.pad = 0;
        u.a = gather ? A : A + (size_t)rt * BM * lda * 2;
        u.b = Bt + (size_t)e * bstride + (size_t)u.pn * BM * (bstride / (ncol * BM)); return true;
    }
    __device__ __forceinline__ unsigned a_row_off(const Unit& u, int r) const { return gather ? (unsigned)rowtab[u.slot * 256 + r] * (unsigned)(lda * 2) : (unsigned)(r * lda * 2); }
};

template <bool ROPE, bool F8 = false>
struct EpiStore {
    static constexpr bool PERM = true; static constexpr int NSTORE = F8 ? 8 : 16;
    bf16_t* O; int ldo; const float* rowscale; int rs; float scale; const float* colscale; const float* CS; int nostore = 0; const float* ssq = nullptr; int ssq_off = 0, ssq_n = 0; float ssq_inv = 0.f; const LAS float* lds_rs = nullptr;
    __device__ __forceinline__ void operator()(const f32x4 (&acc)[2][2][4][2], const Unit& u, int wr, int wc, int fr, int fq) const {
        const int row0 = u.pm * BM + wr * 64 + fr, col0 = u.pn * BM + wc * 32 + 8 * fq;
        float rsc[2][4];
#pragma unroll
        for (int ai = 0; ai < 2; ++ai)
#pragma unroll
            for (int m = 0; m < 4; ++m) {
                if (lds_rs) rsc[ai][m] = scale * lds_rs[u.slot * 256 + wr * 64 + fr + ai * HALF + m * 16];
                else if (ssq) { const float* p = ssq + (size_t)(row0 + ai * HALF + m * 16) * 24 + ssq_off; float s = hsum4(*(const f32x4*)p) + hsum4(*(const f32x4*)(p + 4)); if (ssq_n == 12) s += hsum4(*(const f32x4*)(p + 8));
                    rsc[ai][m] = scale / sqrtf(s * ssq_inv + RMS_EPS); }
                else rsc[ai][m] = rowscale ? scale * rowscale[(size_t)(row0 + ai * HALF + m * 16) * rs] : scale; }
        f32x4 cs[2][2];
#pragma unroll
        for (int bj = 0; bj < 2; ++bj) { cs[bj][0] = (f32x4){1.f, 1.f, 1.f, 1.f}; cs[bj][1] = cs[bj][0];
            if (colscale) { cs[bj][0] = *(const f32x4*)(colscale + col0 + bj * HALF); cs[bj][1] = *(const f32x4*)(colscale + col0 + bj * HALF + 4); } }
        const int g0 = col0 >> 5; const bool rope0 = ROPE && ((g0 % 3) == 2), rope1 = ROPE && (((g0 + 4) % 3) == 2);
#define EPI_STORE_PLAIN(bj, ai) do { if (F8) { _Pragma("unroll") for (int m = 0; m < 4; m += 2) { const float sA = rsc[ai][m], sB = rsc[ai][m + 1]; \
            const f32x4 a0 = acc[ai][bj][m][0] * sA * cs[bj][0], a1 = acc[ai][bj][m][1] * sA * cs[bj][1], b0 = acc[ai][bj][m + 1][0] * sB * cs[bj][0], b1 = acc[ai][bj][m + 1][1] * sB * cs[bj][1]; \
            unsigned xA = pack_f8x4(a0[0], a0[1], a0[2], a0[3]), yA = pack_f8x4(a1[0], a1[1], a1[2], a1[3]), xB = pack_f8x4(b0[0], b0[1], b0[2], b0[3]), yB = pack_f8x4(b1[0], b1[1], b1[2], b1[3]); \
            { auto r_ = __builtin_amdgcn_permlane16_swap(xA, xB, false, false); xA = r_[0]; xB = r_[1]; } { auto r_ = __builtin_amdgcn_permlane16_swap(yA, yB, false, false); yA = r_[0]; yB = r_[1]; } \
            const int row = row0 + (ai) * HALF + (m + (fq & 1)) * 16; \
            *(u32x4*)((unsigned char*)O + ((unsigned)row * (unsigned)ldo + (unsigned)(col0 + (bj) * HALF - ((fq & 1) ? 8 : 0)))) = (u32x4){xA, yA, xB, yB}; } } \
        else { _Pragma("unroll") for (int m = 0; m < 4; ++m) { const int row = row0 + (ai) * HALF + m * 16; const float s = rsc[ai][m]; \
            const f32x4 v0 = acc[ai][bj][m][0] * s * cs[bj][0], v1 = acc[ai][bj][m][1] * s * cs[bj][1]; \
            u32x4 w; w.x = cvt_pk_bf16(v0[0], v0[1]); w.y = cvt_pk_bf16(v0[2], v0[3]); w.z = cvt_pk_bf16(v1[0], v1[1]); w.w = cvt_pk_bf16(v1[2], v1[3]); \
            *(u32x4*)((unsigned char*)O + ((unsigned)row * (unsigned)ldo + (unsigned)(col0 + (bj) * HALF)) * 2u) = w; } } } while (0)
#define EPI_LOAD_CS(ai) do { _Pragma("unroll") for (int m = 0; m < 4; ++m) { const float* cp = CS + (size_t)(row0 + (ai) * HALF + m * 16) * 32 + 4 * fq; c4[m] = *(const f32x4*)cp; s4[m] = *(const f32x4*)(cp + 16); } } while (0)
#define EPI_STORE_ROPE(bj, ai) do { _Pragma("unroll") for (int m = 0; m < 4; ++m) { const int row = row0 + (ai) * HALF + m * 16; const float s = rsc[ai][m]; \
            const f32x4 v0 = acc[ai][bj][m][0] * s, v1 = acc[ai][bj][m][1] * s; \
            const f32x4 y0 = v0 * c4[m] - v1 * s4[m], y1 = v0 * s4[m] + v1 * c4[m]; \
            bf16_t* gp = O + (size_t)row * ldo + (col0 + (bj) * HALF - 8 * fq); \
            u32x2 w0, w1; w0.x = cvt_pk_bf16(y0[0], y0[1]); w0.y = cvt_pk_bf16(y0[2], y0[3]); w1.x = cvt_pk_bf16(y1[0], y1[1]); w1.y = cvt_pk_bf16(y1[2], y1[3]); \
            *(u32x2*)(gp + 4 * fq) = w0; *(u32x2*)(gp + 16 + 4 * fq) = w1; } } while (0)
        if (rope0) {
            f32x4 c4[4], s4[4];
            EPI_LOAD_CS(0); EPI_STORE_ROPE(0, 0);
            EPI_LOAD_CS(1);
            EPI_STORE_PLAIN(1, 0); EPI_STORE_PLAIN(1, 1);
            EPI_STORE_ROPE(0, 1);
        } else if (rope1) {
            f32x4 c4[4], s4[4];
            EPI_LOAD_CS(0); EPI_STORE_ROPE(1, 0);
            EPI_LOAD_CS(1);
            EPI_STORE_PLAIN(0, 0); EPI_STORE_PLAIN(0, 1);
            EPI_STORE_ROPE(1, 1);
        } else {
            EPI_STORE_PLAIN(0, 0); EPI_STORE_PLAIN(0, 1); EPI_STORE_PLAIN(1, 0); EPI_STORE_PLAIN(1, 1);
        }
#undef EPI_STORE_PLAIN
#undef EPI_LOAD_CS
#undef EPI_STORE_ROPE
    }
};
struct EpiZ {
    static constexpr bool PERM = true; static constexpr int NSTORE = 16;
    bf16_t* Z; float* SSQ; bf16_t* KR; const float* CS;
    __device__ __forceinline__ void operator()(const f32x4 (&acc)[2][2][4][2], const Unit& u, int wr, int wc, int fr, int fq) const {
        const int row0 = u.pm * BM + wr * 64 + fr, col0 = u.pn * BM + wc * 32 + 8 * fq;
#pragma unroll
        for (int bj = 0; bj < 2; ++bj) {
            const int h = 2 * u.pn + bj;
            if (h < 5) {
#pragma unroll
                for (int ai = 0; ai < 2; ++ai)
#pragma unroll
                    for (int m = 0; m < 4; ++m) { const int row = row0 + ai * HALF + m * 16; const f32x4 v0 = acc[ai][bj][m][0], v1 = acc[ai][bj][m][1];
                        u32x4 w; w.x = cvt_pk_bf16(v0[0], v0[1]); w.y = cvt_pk_bf16(v0[2], v0[3]); w.z = cvt_pk_bf16(v1[0], v1[1]); w.w = cvt_pk_bf16(v1[2], v1[3]);
                        *(u32x4*)(Z + (size_t)row * ZP + col0 + bj * HALF) = w;
                        float s = hsum4(v0 * v0) + hsum4(v1 * v1); s += __shfl_xor(s, 16); s += __shfl_xor(s, 32);
                        if (fq == 0) SSQ[(size_t)row * 24 + h * 4 + wc] = s; }
            } else if (wc == 0) {
#pragma unroll
                for (int ai = 0; ai < 2; ++ai) { f32x4 c4[4], s4[4];
#pragma unroll
                    for (int m = 0; m < 4; ++m) { const float* cp = CS + (size_t)(row0 + ai * HALF + m * 16) * 32 + 4 * fq; c4[m] = *(const f32x4*)cp; s4[m] = *(const f32x4*)(cp + 16); }
#pragma unroll
                    for (int m = 0; m < 4; ++m) { const int row = row0 + ai * HALF + m * 16; const f32x4 v0 = acc[ai][bj][m][0], v1 = acc[ai][bj][m][1];
                        const f32x4 y0 = v0 * c4[m] - v1 * s4[m], y1 = v0 * s4[m] + v1 * c4[m];
                        u32x2 w0, w1; w0.x = cvt_pk_bf16(y0[0], y0[1]); w0.y = cvt_pk_bf16(y0[2], y0[3]); w1.x = cvt_pk_bf16(y1[0], y1[1]); w1.y = cvt_pk_bf16(y1[2], y1[3]);
                        *(u32x2*)(KR + (size_t)row * 32 + 4 * fq) = w0; *(u32x2*)(KR + (size_t)row * 32 + 16 + 4 * fq) = w1; } }
            }
        }
    }
};
struct EpiGU {
    static constexpr bool PERM = true; static constexpr int NSTORE = 8;
    bf16_t* HE;
    __device__ __forceinline__ void operator()(const f32x4 (&acc)[2][2][4][2], const Unit& u, int wr, int wc, int fr, int fq) const {
        const int row0 = u.pm * BM + wr * 64 + fr, j0 = u.pn * 128 + wc * 16 + 4 * fq;
#pragma unroll
        for (int ai = 0; ai < 2; ++ai)
#pragma unroll
            for (int m = 0; m < 4; m += 2)
#pragma unroll
                for (int bj = 0; bj < 2; ++bj) { unsigned w[2][2];
#pragma unroll
                    for (int q = 0; q < 2; ++q) { const f32x4 g = acc[ai][bj][m + q][0], up = acc[ai][bj][m + q][1]; f32x4 h;
#pragma unroll
                        for (int x = 0; x < 4; ++x) h[x] = g[x] * __builtin_amdgcn_rcpf(1.f + __expf(-g[x])) * up[x];
                        w[q][0] = cvt_pk_bf16(h[0], h[1]); w[q][1] = cvt_pk_bf16(h[2], h[3]); }
                    { auto r_ = __builtin_amdgcn_permlane16_swap(w[0][0], w[1][0], false, false); w[0][0] = r_[0]; w[1][0] = r_[1]; }
                    { auto r_ = __builtin_amdgcn_permlane16_swap(w[0][1], w[1][1], false, false); w[0][1] = r_[0]; w[1][1] = r_[1]; }
                    bf16_t* p = HE + (size_t)(row0 + ai * HALF + (m + (fq & 1)) * 16) * FF + j0 + bj * 64 - ((fq & 1) ? 4 : 0);
                    *(u32x4*)p = (u32x4){w[0][0], w[0][1], w[1][0], w[1][1]}; }
    }
};

template <class Epi, class Sched, bool ALIGN_EPI>
__device__ __forceinline__ void gemm_phase(LAS unsigned char* lds, const int K, const int ldb, const Sched& S, const Epi& E) {
    const int tid = threadIdx.x, wid = __builtin_amdgcn_readfirstlane(tid >> 6), lane = tid & 63, wr = wid >> 2, wc = wid & 3, fr = lane & 15, fq = lane >> 4;
    const int nt = K / BK;
    int RA[2]; unsigned CA2[2], voffB[2];
#pragma unroll
    for (int i = 0; i < 2; ++i) { int R, C; stage_rc(tid * 16 + i * 8192, R, C); const int Rb = Epi::PERM ? ((R & ~31) + perm32(R & 31)) : R;
        RA[i] = R; CA2[i] = (unsigned)C * 2u; voffB[i] = (unsigned)(Rb * ldb + C) * 2u; }
    const size_t kstep = (size_t)(BK * 2);
    const size_t hstepB = (size_t)HALF * ldb * 2;
    const unsigned ldsw = (unsigned)wid * 1024u;
    const int aoff = lds_byte(wr * 64 + fr, fq * 8), boff = lds_byte(wc * 32 + fr, fq * 8);
#define PG8_SA(b, h) (((b) * 2 + (h)) * HTB)
#define PG8_SB(b, h) ((4 + (b) * 2 + (h)) * HTB)
#define PG8_STAGE_B(bufoff, gbase) do { _Pragma("unroll") for (int _i = 0; _i < 2; ++_i) \
        __builtin_amdgcn_global_load_lds((const unsigned*)((const char*)(gbase) + voffB[_i]), (LAS unsigned*)(lds + (bufoff) + ldsw + _i * 8192), 16, 0, 0); } while (0)
#define PG8_STAGE_A(bufoff, gbase, v) do { _Pragma("unroll") for (int _i = 0; _i < 2; ++_i) \
        __builtin_amdgcn_global_load_lds((const unsigned*)((const char*)(gbase) + (v)[_i]), (LAS unsigned*)(lds + (bufoff) + ldsw + _i * 8192), 16, 0, 0); } while (0)
#define PG8_LDA(dst, b, h) do { _Pragma("unroll") for (int m = 0; m < 4; ++m) _Pragma("unroll") for (int k = 0; k < 2; ++k) dst[m][k] = *(const LAS bf16x8*)(lds + PG8_SA(b, h) + aoff + m * 2048 + k * 1024); } while (0)
#define PG8_LDB(dst, b, h) do { _Pragma("unroll") for (int n = 0; n < 2; ++n) _Pragma("unroll") for (int k = 0; k < 2; ++k) dst[n][k] = *(const LAS bf16x8*)(lds + PG8_SB(b, h) + boff + n * 2048 + k * 1024); } while (0)
#define PG8_MMA(ai, bj, At, Bt) do { __builtin_amdgcn_s_setprio(1); _Pragma("unroll") for (int m = 0; m < 4; ++m) _Pragma("unroll") for (int n = 0; n < 2; ++n) _Pragma("unroll") for (int k = 0; k < 2; ++k) \
        acc[ai][bj][m][n] = __builtin_amdgcn_mfma_f32_16x16x32_bf16(Bt[n][k], At[m][k], acc[ai][bj][m][n], 0, 0, 0); __builtin_amdgcn_s_setprio(0); } while (0)
#define PG8_WAIT_V(n) asm volatile("s_waitcnt vmcnt(" #n ")" ::: "memory")
#define PG8_WAIT_L(n) asm volatile("s_waitcnt lgkmcnt(" #n ")" ::: "memory")
#define PG8_BAR __builtin_amdgcn_s_barrier()
#define PG8_SCHED __builtin_amdgcn_sched_barrier(0)
    Unit cur, nxt; int ui = 0;
    if (!S.next(0, cur)) return;
    f32x4 acc[2][2][4][2];
#pragma unroll
    for (int a = 0; a < 2; ++a)
#pragma unroll
        for (int b = 0; b < 2; ++b)
#pragma unroll
            for (int m = 0; m < 4; ++m)
#pragma unroll
                for (int n = 0; n < 2; ++n) acc[a][b][m][n] = (f32x4){0.f, 0.f, 0.f, 0.f};
    bf16x8 At[4][2], B0[2][2], B1[2][2];
    unsigned vA[2][2], nvA[2][2];
#pragma unroll
    for (int h = 0; h < 2; ++h)
#pragma unroll
        for (int i = 0; i < 2; ++i) vA[h][i] = S.a_row_off(cur, h * HALF + RA[i]) + CA2[i];
    const char* cA = cur.a; const char* cB = cur.b;
    PG8_STAGE_B(PG8_SB(0, 0), cB); PG8_STAGE_B(PG8_SB(0, 1), cB + hstepB); PG8_STAGE_A(PG8_SA(0, 0), cA, vA[0]); PG8_STAGE_A(PG8_SA(0, 1), cA, vA[1]);
    if (wr == 1) PG8_BAR;
    PG8_WAIT_V(2); PG8_BAR;
    PG8_STAGE_B(PG8_SB(1, 0), cB + kstep); PG8_STAGE_A(PG8_SA(1, 0), cA + kstep, vA[0]); PG8_STAGE_B(PG8_SB(1, 1), cB + hstepB + kstep);
    PG8_WAIT_V(6); PG8_BAR;
    for (;;) {
        const bool has_next = S.next(ui + 1, nxt);
        const char* nA = has_next ? nxt.a : cA; const char* nB = has_next ? nxt.b : cB;
#pragma unroll
        for (int h = 0; h < 2; ++h)
#pragma unroll
            for (int i = 0; i < 2; ++i) nvA[h][i] = has_next ? (S.a_row_off(nxt, h * HALF + RA[i]) + CA2[i]) : vA[h][i];
#pragma unroll 1
        for (int t = 0; t < nt; t += 2) {
            const bool last = (t == nt - 2);
            const char* a1 = cA + (size_t)(t + 1) * kstep;
            const char* a2 = last ? nA : cA + (size_t)(t + 2) * kstep; const char* b2 = last ? nB : cB + (size_t)(t + 2) * kstep;
            const char* a3 = a2 + kstep; const char* b3 = b2 + kstep;
            unsigned wA0[2], wA1[2];
#pragma unroll
            for (int i = 0; i < 2; ++i) { wA0[i] = last ? nvA[0][i] : vA[0][i]; wA1[i] = last ? nvA[1][i] : vA[1][i]; }
            const bool after_epi = (t == 0) && (ui > 0);
            PG8_LDB(B0, 0, 0); PG8_LDB(B1, 0, 1); PG8_SCHED; PG8_LDA(At, 0, 0); PG8_STAGE_A(PG8_SA(1, 1), a1, vA[1]);
            if (after_epi) { if constexpr (Epi::NSTORE >= 16) PG8_WAIT_V(24); else PG8_WAIT_V(16); } else PG8_WAIT_V(8);
            PG8_WAIT_L(0); PG8_BAR; PG8_MMA(0, 0, At, B0); PG8_MMA(0, 1, At, B1); PG8_BAR; PG8_SCHED;
            PG8_LDA(At, 0, 1); PG8_STAGE_B(PG8_SB(0, 0), b2); PG8_STAGE_B(PG8_SB(0, 1), b2 + hstepB); PG8_STAGE_A(PG8_SA(0, 0), a2, wA0);
            if (after_epi) { if constexpr (Epi::NSTORE >= 16) PG8_WAIT_V(24); else PG8_WAIT_V(16); } else PG8_WAIT_V(8);
            PG8_WAIT_L(0); PG8_BAR; PG8_MMA(1, 0, At, B0); PG8_MMA(1, 1, At, B1); PG8_BAR; PG8_SCHED;
            PG8_LDB(B0, 1, 0); PG8_LDB(B1, 1, 1); PG8_SCHED; PG8_LDA(At, 1, 0); PG8_STAGE_A(PG8_SA(0, 1), a2, wA1);
            PG8_WAIT_V(8); PG8_WAIT_L(0); PG8_BAR; PG8_MMA(0, 0, At, B0); PG8_MMA(0, 1, At, B1); PG8_BAR; PG8_SCHED;
            PG8_LDA(At, 1, 1); PG8_STAGE_B(PG8_SB(1, 0), b3); PG8_STAGE_B(PG8_SB(1, 1), b3 + hstepB); PG8_STAGE_A(PG8_SA(1, 0), a3, wA0);
            PG8_WAIT_V(8); PG8_WAIT_L(0); PG8_BAR; PG8_MMA(1, 0, At, B0); PG8_MMA(1, 1, At, B1); PG8_BAR; PG8_SCHED;
        }
        if constexpr (ALIGN_EPI) { if (wr == 0) PG8_BAR; }
        E(acc, cur, wr, wc, fr, fq);
        if (!has_next) break;
#pragma unroll
        for (int a = 0; a < 2; ++a)
#pragma unroll
            for (int b = 0; b < 2; ++b)
#pragma unroll
                for (int m = 0; m < 4; ++m)
#pragma unroll
                    for (int n = 0; n < 2; ++n) acc[a][b][m][n] = (f32x4){0.f, 0.f, 0.f, 0.f};
        cur = nxt; cA = nA; cB = nB; ++ui;
#pragma unroll
        for (int h = 0; h < 2; ++h)
#pragma unroll
            for (int i = 0; i < 2; ++i) vA[h][i] = nvA[h][i];
        if constexpr (ALIGN_EPI) { if (wr == 1) PG8_BAR; }
    }
    PG8_WAIT_V(0);
    if constexpr (!ALIGN_EPI) { if (wr == 0) PG8_BAR; }
    PG8_BAR;
#undef PG8_SA
#undef PG8_SB
#undef PG8_STAGE_A
#undef PG8_STAGE_B
#undef PG8_LDA
#undef PG8_LDB
#undef PG8_MMA
#undef PG8_WAIT_V
#undef PG8_WAIT_L
#undef PG8_BAR
#undef PG8_SCHED
}
}
namespace attn {
using bf16x8 = __attribute__((ext_vector_type(8))) short;
using s16x4 = __attribute__((ext_vector_type(4))) short;
using f32x16 = __attribute__((ext_vector_type(16))) float;
using u32x4 = __attribute__((ext_vector_type(4))) unsigned;
constexpr int NW = 8, QBLK = 32, QB = 256, KVBLK = 64, NQB = SEQ / QB;
constexpr int KSLOT = 12288, VSLOT = 8192, NKS = 4, NVS = 3;
constexpr int LDS_K = 0, LDS_V = NKS * KSLOT, LDS_WS = LDS_V + NVS * VSLOT, LDS_OST = LDS_WS + NW * 256, LDS_BYTES = LDS_OST + NW * 4096;
__device__ __forceinline__ int crow(int r, int hi) { return (r & 3) + 8 * (r >> 2) + 4 * hi; }
#define SBAR() __builtin_amdgcn_sched_barrier(0)
__device__ __forceinline__ void cmask(f32x16& p0, f32x16& p1, int jb, int qrel, int hi) {
    const float NEG = -INFINITY; const int d = qrel - 64 * jb - 4 * hi;
#pragma unroll
    for (int r = 0; r < 16; ++r) { const int cr = (r & 3) + 8 * (r >> 2); if (cr > d) p0[r] = NEG; if (cr + 32 > d) p1[r] = NEG; }
}
__device__ __forceinline__ void glds16(unsigned voff, const void* sbase, unsigned lds_dst) { unsigned keep;
    asm volatile("s_mov_b32 %0, m0\n\ts_mov_b32 m0, %3\n\ts_nop 0\n\tglobal_load_lds_dwordx4 %1, %2\n\ts_mov_b32 m0, %0" : "=&s"(keep) : "v"(voff), "s"(sbase), "s"(lds_dst) : "memory"); }
typedef float f32x2_t __attribute__((ext_vector_type(2))); typedef __bf16 bf16x2_t __attribute__((ext_vector_type(2)));
__device__ __forceinline__ unsigned cvtpk_s(float lo, float hi) { f32x2_t v = {lo, hi}; bf16x2_t b = __builtin_convertvector(v, bf16x2_t); return __builtin_bit_cast(unsigned, b); }
#define WAIT_BAR(N) asm volatile("s_waitcnt vmcnt(" #N ") lgkmcnt(0)\n\ts_barrier" ::: "memory")
__device__ __forceinline__ void wait_bar_n(int n) { if (n >= 3) WAIT_BAR(3); else if (n == 2) WAIT_BAR(2); else if (n == 1) WAIT_BAR(1); else WAIT_BAR(0); }
typedef __attribute__((address_space(3))) const char* lds_cptr;
typedef short v4i16_t __attribute__((ext_vector_type(4)));
#define KFR(kp, i) (*(const __attribute__((address_space(3))) bf16x8*)((kp) + ((i) >> 1) * 2048 + ((i) & 1) * 512))
__device__ __forceinline__ s16x4 vtr(lds_cptr p) { return __builtin_bit_cast(s16x4, __builtin_amdgcn_ds_read_tr16_b64_v4i16((__attribute__((address_space(3))) v4i16_t*)p)); }
__device__ __forceinline__ void pv(f32x16* o, int vb, bf16x8 pa0, bf16x8 pa1, bf16x8 pa2, bf16x8 pa3) {
#pragma unroll
    for (int d0 = 0; d0 < 2; ++d0) { s16x4 lo[4], hi[4];
#pragma unroll
        for (int ks = 0; ks < 4; ++ks) {
            asm volatile("ds_read_b64_tr_b16 %0,%1 offset:%c2" : "=&v"(lo[ks]) : "v"(vb), "i"(d0 * 4096 + ks * 1024) : "memory");
            asm volatile("ds_read_b64_tr_b16 %0,%1 offset:%c2" : "=&v"(hi[ks]) : "v"(vb), "i"(d0 * 4096 + ks * 1024 + 512) : "memory"); }
        asm volatile("s_waitcnt lgkmcnt(0)" ::: "memory"); SBAR();
#define PK(k) (bf16x8){lo[k][0], lo[k][1], lo[k][2], lo[k][3], hi[k][0], hi[k][1], hi[k][2], hi[k][3]}
        o[d0] = __builtin_amdgcn_mfma_f32_32x32x16_bf16(pa0, PK(0), o[d0], 0, 0, 0);
        o[d0] = __builtin_amdgcn_mfma_f32_32x32x16_bf16(pa1, PK(1), o[d0], 0, 0, 0);
        o[d0] = __builtin_amdgcn_mfma_f32_32x32x16_bf16(pa2, PK(2), o[d0], 0, 0, 0);
        o[d0] = __builtin_amdgcn_mfma_f32_32x32x16_bf16(pa3, PK(3), o[d0], 0, 0, 0);
#undef PK
    }
}
template <int THRL>
__device__ __forceinline__ void attn_unit(int b, int h, int qb, const bf16_t* Q, const bf16_t* __restrict__ KVB, const bf16_t* __restrict__ KR, const float* __restrict__ CS, bf16_t* O, char* shm) {
    const int tid = threadIdx.x, lane = tid & 63, r32 = lane & 31, hi = lane >> 5; const int wid = __builtin_amdgcn_readfirstlane(tid >> 6);
    const long rowbase = (long)b * SEQ; const int q0 = qb * QB;
    const unsigned char* Qw = (const unsigned char*)Q + (rowbase + q0 + wid * QBLK) * QP + h * DQK;
    const bf16_t* Kh = KVB + rowbase * KVP + h * 128; const bf16_t* KRb = KR + rowbase * 32;
    const unsigned lds0 = (unsigned)(uintptr_t)shm;
    float* wsf = (float*)(shm + LDS_WS) + wid * 64;
    const unsigned koff = (unsigned)(lane * KVP + wid * 8) * 2u;
    const unsigned roff = (unsigned)(lane * 32 + (wid & 3) * 8) * 2u;
    const unsigned voff = (unsigned)(64 + (16 * (wid & 3) + (lane >> 2)) * KVP + (wid >> 2) * 32 + (lane & 3) * 8) * 2u;
    const unsigned kdst = lds0 + LDS_K + wid * 1024, rdst = lds0 + LDS_K + (8 + (wid & 3)) * 1024, vdst = lds0 + LDS_V + wid * 1024;
    const int nkd = (wid < 4) ? 2 : 1;
#define DMA_K(t) do { glds16(koff, Kh + (long)(t) * KVBLK * KVP, (unsigned)__builtin_amdgcn_readfirstlane(kdst + ((t) & 3) * KSLOT)); \
        if (wid < 4) glds16(roff, KRb + (long)(t) * KVBLK * 32, (unsigned)__builtin_amdgcn_readfirstlane(rdst + ((t) & 3) * KSLOT)); } while (0)
#define DMA_V(t, so) glds16(voff, Kh + (long)(t) * KVBLK * KVP, (unsigned)__builtin_amdgcn_readfirstlane(vdst + (so)))
    const int vb0 = (int)(lds0 + LDS_V) + ((lane >> 4) & 1) * 32 + (lane & 3) * 8 + (4 * hi + ((lane & 15) >> 2)) * 64;
    const lds_cptr shm3 = (lds_cptr)shm; const lds_cptr kp0 = shm3 + LDS_K + hi * 1024 + r32 * 16;
    const lds_cptr vp0 = shm3 + LDS_V + ((lane >> 4) & 1) * 32 + (lane & 3) * 8 + (4 * hi + ((lane & 15) >> 2)) * 64;
    const int NT = (q0 + QB) / KVBLK;
    DMA_K(0); DMA_V(0, 0); DMA_K(1); DMA_V(1, VSLOT); DMA_K(2); DMA_K(3);
    bf16x8 qr[6];
    {
        pg8::u32x2 qraw[6];
#pragma unroll
        for (int d0 = 0; d0 < 6; ++d0) qraw[d0] = *reinterpret_cast<const pg8::u32x2*>(Qw + (long)r32 * QP + d0 * 16 + hi * 8);
        const float* csp = CS + (size_t)(rowbase + q0 + wid * QBLK + r32) * 32 + 8 * hi;
        const f32x4 ca = *(const f32x4*)csp, cb = *(const f32x4*)(csp + 4), sa = *(const f32x4*)(csp + 16), sb = *(const f32x4*)(csp + 20);
#pragma unroll
        for (int d0 = 0; d0 < 4; ++d0) { const f32x4 a = unpack_f8x4(qraw[d0].x) * F8IS, b2 = unpack_f8x4(qraw[d0].y) * F8IS;
            qr[d0] = __builtin_bit_cast(bf16x8, (u32x4){cvtpk_s(a[0], a[1]), cvtpk_s(a[2], a[3]), cvtpk_s(b2[0], b2[1]), cvtpk_s(b2[2], b2[3])}); }
        const f32x4 x1a = unpack_f8x4(qraw[4].x) * F8IS, x1b = unpack_f8x4(qraw[4].y) * F8IS, x2a = unpack_f8x4(qraw[5].x) * F8IS, x2b = unpack_f8x4(qraw[5].y) * F8IS;
        const f32x4 y1a = x1a * ca - x2a * sa, y1b = x1b * cb - x2b * sb, y2a = x1a * sa + x2a * ca, y2b = x1b * sb + x2b * cb;
        qr[4] = __builtin_bit_cast(bf16x8, (u32x4){cvtpk_s(y1a[0], y1a[1]), cvtpk_s(y1a[2], y1a[3]), cvtpk_s(y1b[0], y1b[1]), cvtpk_s(y1b[2], y1b[3])});
        qr[5] = __builtin_bit_cast(bf16x8, (u32x4){cvtpk_s(y2a[0], y2a[1]), cvtpk_s(y2a[2], y2a[3]), cvtpk_s(y2b[0], y2b[1]), cvtpk_s(y2b[2], y2b[3])}); }
    float mhat = 0.f, l_reg = 0.f; f32x16 o[2]; o[0] = f32x16{}; o[1] = f32x16{}; f32x16 negm = f32x16{}; asm volatile("" : "+v"(negm));
    const int qrel = wid * QBLK + r32;
    bool resc = false;
    f32x16 pA0, pA1, pB0, pB1;
    WAIT_BAR(0);
    { const lds_cptr kp_ = kp0;
#pragma unroll
      for (int d0 = 0; d0 < 6; ++d0) { const bf16x8 b0 = KFR(kp_, 2 * d0), b1 = KFR(kp_, 2 * d0 + 1);
          pA0 = __builtin_amdgcn_mfma_f32_32x32x16_bf16(b0, qr[d0], d0 ? pA0 : negm, 0, 0, 0); pA1 = __builtin_amdgcn_mfma_f32_32x32x16_bf16(b1, qr[d0], d0 ? pA1 : negm, 0, 0, 0); }
      if (NT == 4) cmask(pA0, pA1, 0, qrel, hi);
      float a = fmaxf(fmaxf(pA0[0], pA0[1]), pA1[0]), bb = fmaxf(fmaxf(pA0[2], pA0[3]), pA1[1]); a = fmaxf(fmaxf(a, pA1[2]), pA1[3]);
#pragma unroll
      for (int r = 4; r < 16; r += 4) { a = fmaxf(fmaxf(a, pA0[r]), pA0[r + 1]); bb = fmaxf(fmaxf(bb, pA0[r + 2]), pA0[r + 3]); a = fmaxf(fmaxf(a, pA1[r]), pA1[r + 1]); bb = fmaxf(fmaxf(bb, pA1[r + 2]), pA1[r + 3]); }
      float rm = fmaxf(a, bb); { auto rr = __builtin_amdgcn_permlane32_swap(__float_as_uint(rm), __float_as_uint(rm), false, false); rm = fmaxf(__uint_as_float(rr[0]), __uint_as_float(rr[1])); }
      mhat = rm;
#pragma unroll
      for (int r = 0; r < 16; ++r) { pA0[r] = __builtin_amdgcn_exp2f(pA0[r] - rm); pA1[r] = __builtin_amdgcn_exp2f(pA1[r] - rm); }
#pragma unroll
      for (int r = 0; r < 16; ++r) negm[r] = -mhat;
      asm volatile("" : "+v"(negm)); }
    int vs_prev = 0, vs_cur = VSLOT, vs_next = 2 * VSLOT;
#define ROTV() do { const int t_ = vs_prev; vs_prev = vs_cur; vs_cur = vs_next; vs_next = t_; } while (0)
    bf16x8 kq0, kq1, kq2, kq3;
    { const lds_cptr kp_ = kp0 + KSLOT; kq0 = KFR(kp_, 0); kq1 = KFR(kp_, 1); kq2 = KFR(kp_, 2); kq3 = KFR(kp_, 3); }
    WAIT_BAR(0);
    bf16x8 va, vb_, vc; u32x4 pw0, pw1, pw2, pw3;
#define RESC() do { if (resc) { asm volatile("s_waitcnt lgkmcnt(0)" ::: "memory"); \
      _Pragma("unroll") for (int d_ = 0; d_ < 2; ++d_) _Pragma("unroll") for (int r = 0; r < 16; ++r) o[d_][r] *= wsf[crow(r, hi)]; } } while (0)
#define PKW(P, B) cvtpk_s(P[B], P[B + 1])
#define PAF(k) __builtin_bit_cast(bf16x8, pw##k)
#define PIN(x) asm volatile("" : "+v"(x))
#define MX3(a, b, c) __builtin_fmaxf(__builtin_fmaxf((a), (b)), (c))
#define MF(a, b, c) __builtin_amdgcn_mfma_f32_32x32x16_bf16(a, b, c, 0, 0, 0)
#define GAPA(MFS, A0, A1, A2, A3, W0, W1, PW) do { MFS; sacc += A0; sacc += A1; sacc += A2; sacc += A3; PIN(sacc); W0; W1; PIN(PW); SBAR(); } while (0)
#define EX(v) __builtin_amdgcn_exp2f(v)
#define GAPB(MFS, X, B) do { MFS; X[B] = EX(X[B]); X[B + 1] = EX(X[B + 1]); X[B + 2] = EX(X[B + 2]); X[B + 3] = EX(X[B + 3]); PIN(X); SBAR(); } while (0)
#define VLD(dst, i) do { const s16x4 lo_ = vtr(vp_ + (((i) >> 2) * 4096 + ((i) & 3) * 1024)), hi_ = vtr(vp_ + (((i) >> 2) * 4096 + ((i) & 3) * 1024 + 512)); \
        dst = (bf16x8){lo_[0], lo_[1], lo_[2], lo_[3], hi_[0], hi_[1], hi_[2], hi_[3]}; } while (0)
#define KRD(G, j) do { if (G) { if ((j) == 0) kq0 = KFR(kn_, 0); else if ((j) == 1) kq1 = KFR(kn_, 1); else if ((j) == 2) kq2 = KFR(kn_, 2); else kq3 = KFR(kn_, 3); } } while (0)
#define STEP(C0, C1, P0, P1, t, GK, GV, GL, MASK) do { SBAR(); \
    const lds_cptr vp_ = vp0 + vs_prev; const lds_cptr kp_ = kp0 + ((t) & 3) * KSLOT; const lds_cptr kn_ = kp0 + (((t) + 1) & 3) * KSLOT; \
    float sacc = (P0[0] + P0[1]); \
    GAPA(C0 = MF(kq0, qr[0], negm), P0[2], P0[3], P0[4], P0[5],     pw0[0] = PKW(P0, 0), pw0[1] = PKW(P0, 2), pw0); kq0 = KFR(kp_, 4); SBAR(); \
    GAPA(C1 = MF(kq1, qr[0], negm), P0[6], P0[7], P0[8], P0[9],     pw0[2] = PKW(P0, 4), pw0[3] = PKW(P0, 6), pw0); kq1 = KFR(kp_, 5); SBAR(); \
    GAPA(C0 = MF(kq2, qr[1], C0),   P0[10], P0[11], P0[12], P0[13], pw1[0] = PKW(P0, 8), pw1[1] = PKW(P0, 10), pw1); kq2 = KFR(kp_, 6); SBAR(); \
    GAPA(C1 = MF(kq3, qr[1], C1),   P0[14], P0[15], P1[0], P1[1],   pw1[2] = PKW(P0, 12), pw1[3] = PKW(P0, 14), pw1); kq3 = KFR(kp_, 7); SBAR(); \
    GAPA(C0 = MF(kq0, qr[2], C0),   P1[2], P1[3], P1[4], P1[5],     pw2[0] = PKW(P1, 0), pw2[1] = PKW(P1, 2), pw2); kq0 = KFR(kp_, 8); SBAR(); \
    GAPA(C1 = MF(kq1, qr[2], C1),   P1[6], P1[7], P1[8], P1[9],     pw2[2] = PKW(P1, 4), pw2[3] = PKW(P1, 6), pw2); kq1 = KFR(kp_, 9); SBAR(); \
    GAPA(C0 = MF(kq2, qr[3], C0),   P1[10], P1[11], P1[12], P1[13], pw3[0] = PKW(P1, 8), pw3[1] = PKW(P1, 10), pw3); kq2 = KFR(kp_, 10); SBAR(); \
    GAPA(C1 = MF(kq3, qr[3], C1),   P1[14], P1[15], 0.f, 0.f,       pw3[2] = PKW(P1, 12), pw3[3] = PKW(P1, 14), pw3); kq3 = KFR(kp_, 11); SBAR(); \
    C0 = MF(kq0, qr[4], C0); VLD(va, 0); SBAR(); C1 = MF(kq1, qr[4], C1); VLD(vb_, 4); SBAR(); C0 = MF(kq2, qr[5], C0); VLD(vc, 1); SBAR(); C1 = MF(kq3, qr[5], C1); SBAR(); \
    l_reg += sacc; \
    if (GK) { DMA_K((t) + 3); } if (GV) { DMA_V((t) + 1, vs_next); } \
    if (MASK) { const int jb_ = (t) - (NT - 4); if (jb_ >= 0) cmask(C0, C1, jb_, qrel, hi); } \
    if (THRL >= 0) { float a = MX3(C0[0], C0[1], C1[0]), b_ = MX3(C0[2], C0[3], C1[1]); a = MX3(a, C1[2], C1[3]); \
      _Pragma("unroll") for (int r = 4; r < 16; r += 4) { a = MX3(a, C0[r], C0[r + 1]); b_ = MX3(b_, C0[r + 2], C0[r + 3]); a = MX3(a, C1[r], C1[r + 1]); b_ = MX3(b_, C1[r + 2], C1[r + 3]); } \
      float rm = __builtin_fmaxf(a, b_); { auto rr = __builtin_amdgcn_permlane32_swap(__float_as_uint(rm), __float_as_uint(rm), false, false); rm = __builtin_fmaxf(__uint_as_float(rr[0]), __uint_as_float(rr[1])); } \
      resc = false; \
      if (__builtin_expect(__any(rm > (float)THRL), 0)) { const float dl = __builtin_fmaxf(rm, 0.f); mhat += dl; \
        _Pragma("unroll") for (int r = 0; r < 16; ++r) { C0[r] -= dl; C1[r] -= dl; } \
        _Pragma("unroll") for (int r = 0; r < 16; ++r) negm[r] = -mhat; asm volatile("" : "+v"(negm)); \
        const float f = __builtin_amdgcn_exp2f(-dl); l_reg *= f; if (hi == 0) wsf[r32] = f; resc = true; } } \
    else {     \
      float rs_ = sacc; { auto rr = __builtin_amdgcn_permlane32_swap(__float_as_uint(rs_), __float_as_uint(rs_), false, false); rs_ = __uint_as_float(rr[0]) + __uint_as_float(rr[1]); } \
      resc = false; \
      if (__builtin_expect(__any(rs_ > 16777216.f), 0)) { const float dl = (rs_ > 16777216.f) ? (float)(((int)(__float_as_uint(rs_) >> 23) & 255) - 127) : 0.f; mhat += dl; \
        _Pragma("unroll") for (int r = 0; r < 16; ++r) { C0[r] -= dl; C1[r] -= dl; } \
        _Pragma("unroll") for (int r = 0; r < 16; ++r) negm[r] = -mhat; asm volatile("" : "+v"(negm)); \
        const float f = __builtin_amdgcn_exp2f(-dl); l_reg *= f; if (hi == 0) wsf[r32] = f; resc = true; } } \
    SBAR(); \
    GAPB(o[0] = MF(PAF(0), va, o[0]), C0, 0);  VLD(va, 5); SBAR(); \
    GAPB(o[1] = MF(PAF(0), vb_, o[1]), C0, 4); VLD(vb_, 2); SBAR(); \
    GAPB(o[0] = MF(PAF(1), vc, o[0]), C0, 8);  VLD(vc, 6); KRD(GL, 0); SBAR(); \
    GAPB(o[1] = MF(PAF(1), va, o[1]), C0, 12); VLD(va, 3); KRD(GL, 1); SBAR(); \
    GAPB(o[0] = MF(PAF(2), vb_, o[0]), C1, 0); VLD(vb_, 7); KRD(GL, 2); SBAR(); \
    GAPB(o[1] = MF(PAF(2), vc, o[1]), C1, 4);  KRD(GL, 3); SBAR(); \
    GAPB(o[0] = MF(PAF(3), va, o[0]), C1, 8); \
    GAPB(o[1] = MF(PAF(3), vb_, o[1]), C1, 12); \
    } while (0)
    int t = 1;
    for (; t + 5 < NT; t += 2) {
        STEP(pB0, pB1, pA0, pA1, t, true, true, true, false);         if (wid < 4) WAIT_BAR(3); else WAIT_BAR(2); RESC(); ROTV();
        STEP(pA0, pA1, pB0, pB1, t + 1, true, true, true, false);     if (wid < 4) WAIT_BAR(3); else WAIT_BAR(2); RESC(); ROTV();
    }
#define ENDW(tt) wait_bar_n(((tt) + 2 < NT) ? ((((tt) + 3 < NT) ? nkd : 0) + 1) : 0)
    for (; t + 1 < NT; t += 2) {
        STEP(pB0, pB1, pA0, pA1, t, (t + 3 < NT), (t + 1 < NT), (t + 1 < NT), true);         ENDW(t);     RESC(); ROTV();
        STEP(pA0, pA1, pB0, pB1, t + 1, (t + 4 < NT), (t + 2 < NT), (t + 2 < NT), true);     ENDW(t + 1); RESC(); ROTV();
    }
    STEP(pB0, pB1, pA0, pA1, NT - 1, false, false, false, true); RESC();
    { float sacc = pB0[0] + pB0[1];
#pragma unroll
      for (int r = 2; r < 16; ++r) sacc += pB0[r];
#pragma unroll
      for (int r = 0; r < 16; ++r) sacc += pB1[r];
      l_reg += sacc;
      pw0 = (u32x4){PKW(pB0, 0), PKW(pB0, 2), PKW(pB0, 4), PKW(pB0, 6)}; pw1 = (u32x4){PKW(pB0, 8), PKW(pB0, 10), PKW(pB0, 12), PKW(pB0, 14)};
      pw2 = (u32x4){PKW(pB1, 0), PKW(pB1, 2), PKW(pB1, 4), PKW(pB1, 6)}; pw3 = (u32x4){PKW(pB1, 8), PKW(pB1, 10), PKW(pB1, 12), PKW(pB1, 14)};
      SBAR(); pv(o, vb0 + vs_cur, PAF(0), PAF(1), PAF(2), PAF(3)); }
#undef PKW
#undef PAF
#undef PIN
#undef MX3
#undef MF
#undef GAPA
#undef GAPB
#undef EX
#undef VLD
#undef KRD
#undef STEP
#undef ENDW
    { auto rr = __builtin_amdgcn_permlane32_swap(__float_as_uint(l_reg), __float_as_uint(l_reg), false, false); l_reg = __uint_as_float(rr[0]) + __uint_as_float(rr[1]); }
    if (hi == 0) wsf[32 + r32] = l_reg; asm volatile("s_waitcnt lgkmcnt(0)" ::: "memory");
    float rli[16];
#pragma unroll
    for (int r = 0; r < 16; ++r) rli[r] = __builtin_amdgcn_rcpf(wsf[32 + crow(r, hi)]);
    bf16_t* Ow = O + (rowbase + q0 + wid * QBLK) * DM + h * DV;
    { bf16_t* stg = (bf16_t*)(shm + LDS_OST) + wid * 2048;
#pragma unroll
      for (int r = 0; r < 16; ++r) { const int orow = crow(r, hi);
#pragma unroll
          for (int d0 = 0; d0 < 2; ++d0) stg[orow * 64 + d0 * 32 + r32] = f2bf(o[d0][r] * rli[r]); }
      asm volatile("s_waitcnt lgkmcnt(0)" ::: "memory");
#pragma unroll
      for (int i = 0; i < 4; ++i) { const int row = i * 8 + (lane >> 3), ch = lane & 7; const u32x4 v = *(const u32x4*)(stg + row * 64 + ch * 8); *(u32x4*)(Ow + (long)row * DM + ch * 8) = v; } }
    asm volatile("s_waitcnt lgkmcnt(0)\n\ts_barrier" ::: "memory");
#undef DMA_K
#undef DMA_V
#undef RESC
#undef ROTV
}
template <int THRL = 8>
__device__ __forceinline__ void attn_phase(char* lds, const bf16_t* Q, const bf16_t* KVB, const bf16_t* KR, const float* CS, bf16_t* O, int vcu, int G) {
    for (int hh = vcu; hh < BATCH * NH * 2; hh += G) {
        const int xg = hh >> 5, g = (hh >> 3) & 3, j = hh & 7;
#pragma unroll 1
        for (int i = 0; i < 8; ++i) { const int bh = xg * 16 + (i >> 1) * 4 + g; const int qb = (i & 1) ? 15 - j : j; attn_unit<THRL>(bh / NH, bh % NH, qb, Q, KVB, KR, CS, O, lds); }
    }
}
#undef SBAR
#undef WAIT_BAR
#undef KFR
}
constexpr int NWAVES = 8;
constexpr int RING_OFF = 0, RING_BYTES = 131072;
constexpr int ROWTAB_OFF = 131072;
constexpr int TB_OFF = ROWTAB_OFF + 4096;
constexpr int MISC_OFF = LN1_LDS_BYTES;
constexpr int LDS_BYTES = MISC_OFF + 256;
static_assert(TB_OFF + 256 <= MISC_OFF && attn::LDS_BYTES <= RING_BYTES && LDS_BYTES <= 160 * 1024, "LDS map");
#define GAS __attribute__((address_space(1)))
typedef GAS unsigned gu32;
#define RLX_AGENT __ATOMIC_RELAXED, __HIP_MEMORY_SCOPE_AGENT
constexpr int CW_BAR = 4096;

#define XB_TMO      128
#define XB_XCNT(j)  (256  + 64 * (j))
#define XB_XSUB(j)  (1280 + 64 * (j))
#define XB_XGEN(j)  (2304 + 64 * (j))
#define XB_TOP      3328
#define XB_TOPGEN   3392
#define XCD_BAR_WORDS 3456
#define XB_SPIN_CAP (1u << 18)
static_assert((CW_BAR + XCD_BAR_WORDS) * 4 <= (int)CTL_ZERO_BYTES && (CW_CNT + 128) * 4 <= CW_BAR * 4, "control words inside the per-call memset");
__device__ __forceinline__ unsigned xb_ld(unsigned* p)              { return __hip_atomic_load(p, __ATOMIC_RELAXED, __HIP_MEMORY_SCOPE_AGENT); }
__device__ __forceinline__ unsigned xb_add(unsigned* p, unsigned v) { return __hip_atomic_fetch_add(p, v, __ATOMIC_RELAXED, __HIP_MEMORY_SCOPE_AGENT); }
__device__ __forceinline__ unsigned xb_xcc_id() { return (unsigned)__builtin_amdgcn_s_getreg((3 << 11) | 20) & 0xFu; }
#define XB_SPIN(cond, bar) do { unsigned _sp = 0; while (cond) { __builtin_amdgcn_s_sleep(1); \
    if ((++_sp & 255u) == 0u) { if (xb_ld(&(bar)[XB_TMO])) break; if (_sp > XB_SPIN_CAP) { atomicAdd(&(bar)[XB_TMO], 1u); break; } } } } while (0)
struct XcdBarrier { unsigned* bar; unsigned x; volatile LAS unsigned* st; };
__device__ __forceinline__ XcdBarrier xcd_barrier_post(unsigned* bar, volatile LAS unsigned* st) {
    XcdBarrier b; b.bar = bar; b.x = xb_xcc_id(); b.st = st;
    if (threadIdx.x == 0) (void)xb_add(&bar[XB_XCNT(b.x)], 1u);
    return b;
}
__device__ __forceinline__ void xcd_barrier_complete(unsigned* bar, unsigned x, unsigned& nloc, unsigned& nx) {
    const unsigned G = gridDim.x * gridDim.y * gridDim.z;
    unsigned sum, cnt, mine, sp = 0u;
    for (;;) {
        sum = 0u; cnt = 0u; mine = 0u;
#pragma unroll
        for (unsigned j = 0; j < 16; ++j) { const unsigned c = xb_ld(&bar[XB_XCNT(j)]); sum += c; cnt += (c > 0u) ? 1u : 0u; mine = (j == x) ? c : mine; }
        if (sum == G) break;
        __builtin_amdgcn_s_sleep(1);
        if ((++sp & 255u) == 0u) { if (xb_ld(&bar[XB_TMO])) break; if (sp > XB_SPIN_CAP) { atomicAdd(&bar[XB_TMO], 1u); break; } }
    }
    nloc = mine > 0u ? mine : 1u; nx = cnt > 0u ? cnt : 1u;
}
__device__ __forceinline__ void xcd_barrier(const XcdBarrier& b) {
    asm volatile("s_waitcnt vmcnt(0)" ::: "memory");
    __syncthreads();
    if (threadIdx.x == 0) {
        unsigned* bar = b.bar;
        __builtin_amdgcn_s_waitcnt(0);
        unsigned nloc = b.st[0], nx = b.st[1];
        if (nloc == 0u) { xcd_barrier_complete(bar, b.x, nloc, nx); b.st[0] = nloc; b.st[1] = nx; }
        const unsigned old = xb_add(&bar[XB_XSUB(b.x)], 1u);
        const unsigned gen = old / nloc;
        if (old + 1u == (gen + 1u) * nloc) {
            __builtin_amdgcn_fence(__ATOMIC_RELEASE, "agent");
            asm volatile("s_waitcnt vmcnt(0)" ::: "memory");
            const unsigned og = xb_add(&bar[XB_TOP], 1u);
            const unsigned tg = og / nx;
            if (og + 1u == (tg + 1u) * nx) xb_add(&bar[XB_TOPGEN], 1u);
            else XB_SPIN(xb_ld(&bar[XB_TOPGEN]) == tg, bar);
            __builtin_amdgcn_fence(__ATOMIC_ACQUIRE, "agent");
            xb_add(&bar[XB_XGEN(b.x)], 1u);
            asm volatile("s_waitcnt vmcnt(0)" ::: "memory");
        } else {
            XB_SPIN(xb_ld(&bar[XB_XGEN(b.x)]) == gen, bar);
            __builtin_amdgcn_fence(__ATOMIC_ACQUIRE, "agent");
            asm volatile("s_waitcnt vmcnt(0)" ::: "memory");
        }
    }
    __syncthreads();
}

constexpr int ROWTAB_OFF_ = 131072, TB_OFF_ = 131072 + 4096;
template <bool M1>
__device__ __forceinline__ void moe_gemm(LAS unsigned char* lds, int layer, int G, int c, const unsigned* cnt, const int* list, const bf16_t* A, const bf16_t* W, bf16_t* HE, bf16_t* Y2, int nostore = 0) {
    const int tid = threadIdx.x;
    LAS int* tb = (LAS int*)(lds + TB_OFF_); LAS int* rowtab = (LAS int*)(lds + ROWTAB_OFF_);
    if (tid < 64) { const int cn = (tid < 32) ? (int)cnt[tid] : 0; const int tiles = (cn + 255) >> 8; int incl = tiles;
#pragma unroll
        for (int o = 1; o < 32; o <<= 1) { const int t = __shfl_up(incl, o); if (tid >= o) incl += t; }
        if (tid < 32) tb[tid] = incl - tiles; if (tid == 31) tb[32] = incl; }
    __syncthreads();
    pg8::MoeOrder<M1 ? 2 : 4> S; S.G = G; S.c = c; S.gather = M1 ? 1 : 0; S.tb = tb; S.rowtab = rowtab; S.cnt = cnt; S.A = (const char*)A; S.lda = M1 ? DM : FF;
    S.Bt = (const char*)(W + (size_t)layer * (M1 ? (size_t)NE * 512 * DM : (size_t)NE * DM * FF)); S.bstride = M1 ? (size_t)512 * DM * 2 : (size_t)DM * FF * 2;
    if constexpr (M1) {
        pg8::Unit u;
        for (int i = 0; i < 4; ++i) { if (!S.next(i, u)) break;
            if (tid < 256) { const int r = (u.pm - tb[u.e]) * 256 + tid; rowtab[i * 256 + tid] = (tid < u.cnt) ? list[(size_t)u.e * M + r] : list[(size_t)u.e * M]; } }
        __syncthreads();
        pg8::EpiGU E{HE};
        pg8::gemm_phase<pg8::EpiGU, pg8::MoeOrder<2>, true>(lds, DM, DM, S, E);
    } else {
        pg8::EpiStore<false, true> E{Y2, DM, nullptr, 0, F8S, nullptr, nullptr, nostore};
        pg8::gemm_phase<pg8::EpiStore<false, true>, pg8::MoeOrder<4>, true>(lds, FF, FF, S, E);
    }
}
constexpr int NWAVES_LN = 8;
constexpr int L1M_TS = 1032;
constexpr int L1M_THI = 0, L1M_TLO = 16 * L1M_TS * 2, L1M_RED = 2 * 16 * L1M_TS * 2, L1M_LOG = L1M_RED + 8 * 16 * 48 * 4, L1M_HIST = L1M_LOG + 128 * 48 * 4, L1M_BYTES = L1M_HIST + 256;
template <bool RES_F32, bool YF8_>
__device__ __forceinline__ void rp_ln1m(LAS unsigned char* lds, int layer, const void* res, const bf16_t* ybr, const float* modv_l, const float* lng, const float* lnb,
                                        const float* w_gr, const float* b_gr, const float* w_er, const float* b_er, bf16_t* X1, bf16_t* H2,
                                        int* tok_e, float* tok_w, int* tok_t, unsigned* cnt, int* list, int noroute = 0) {
    typedef short bf16x8 __attribute__((ext_vector_type(8)));
    const int tid = threadIdx.x, lane = tid & 63, wave = __builtin_amdgcn_readfirstlane(tid >> 6), fr = lane & 15, fq = lane >> 4;
    LAS bf16_t* Thi = (LAS bf16_t*)(lds + L1M_THI); LAS bf16_t* Tlo = (LAS bf16_t*)(lds + L1M_TLO);
    LAS float* red = (LAS float*)(lds + L1M_RED); LAS float* lgt = (LAS float*)(lds + L1M_LOG); LAS unsigned* hist = (LAS unsigned*)(lds + L1M_HIST);
    if (tid < 64) hist[tid] = 0u;
    bf16x8 Whi[3][4], Wlo[3][4];
#pragma unroll
    for (int nb = 0; nb < 3; ++nb)
#pragma unroll
        for (int ks = 0; ks < 4; ++ks) { const int n = 16 * nb + fr, k0 = 128 * wave + 32 * ks + 8 * fq; float w[8];
#pragma unroll
            for (int j = 0; j < 8; ++j) w[j] = (n < 4) ? w_gr[(size_t)layer * DM * 4 + (k0 + j) * 4 + n] : ((n < NRT) ? w_er[(size_t)layer * DM * 32 + (k0 + j) * 32 + (n - 4)] : 0.f);
            unsigned h[4], l[4];
#pragma unroll
            for (int j = 0; j < 4; ++j) { h[j] = cvt_pk_bf16(w[2 * j], w[2 * j + 1]); l[j] = cvt_pk_bf16(w[2 * j] - __uint_as_float(h[j] << 16), w[2 * j + 1] - __uint_as_float(h[j] & 0xffff0000u)); }
            Whi[nb][ks] = __builtin_bit_cast(bf16x8, (pg8::u32x4){h[0], h[1], h[2], h[3]}); Wlo[nb][ks] = __builtin_bit_cast(bf16x8, (pg8::u32x4){l[0], l[1], l[2], l[3]}); }
    __syncthreads();
    const int rows_per_blk = M / gridDim.x; const int vb_ = (gridDim.x % 8 == 0) ? (int)((blockIdx.x % 8) * (gridDim.x / 8) + blockIdx.x / 8) : (int)blockIdx.x;
    const int row0 = vb_ * rows_per_blk;
    f32x4 pres[2][2][2]; pg8::u32x4 presb[2][2], pyb[2][2]; pg8::u32x2 py[2][2];
#define L1M_LOADG(gg) do { _Pragma("unroll") for (int r = 0; r < 2; ++r) { const size_t mo_ = (size_t)(row0 + 16 * (gg) + 2 * wave + r) * DM; \
        _Pragma("unroll") for (int jp = 0; jp < 2; ++jp) { const int e = 8 * lane + 512 * jp; \
            if (RES_F32) { pres[r][jp][0] = *(const f32x4*)((const float*)res + mo_ + e); pres[r][jp][1] = *(const f32x4*)((const float*)res + mo_ + e + 4); } else presb[r][jp] = *(const pg8::u32x4*)((const bf16_t*)res + mo_ + e); \
            if (YF8_) py[r][jp] = *(const pg8::u32x2*)((const unsigned char*)ybr + mo_ + e); else pyb[r][jp] = *(const pg8::u32x4*)(ybr + mo_ + e); } } } while (0)
#define L1M_BF2(lo_, hi_) ((f32x4){__uint_as_float((lo_) << 16), __uint_as_float((lo_) & 0xffff0000u), __uint_as_float((hi_) << 16), __uint_as_float((hi_) & 0xffff0000u)})
    const int ngrp = rows_per_blk / 16;
    L1M_LOADG(0);
    for (int g = 0; g < ngrp; ++g) {
        f32x4 u[2][2][2]; float mean[2], rs[2];
        { const int b = (row0 + 16 * g) / SEQ; const float* mv = modv_l + (size_t)b * 6 * DM;
#pragma unroll
          for (int r = 0; r < 2; ++r) { float s = 0.f;
#pragma unroll
            for (int jp = 0; jp < 2; ++jp)
#pragma unroll
              for (int q = 0; q < 2; ++q) { const int e = 8 * lane + 512 * jp + 4 * q;
                const f32x4 rv = RES_F32 ? pres[r][jp][q] : (q ? L1M_BF2(presb[r][jp].z, presb[r][jp].w) : L1M_BF2(presb[r][jp].x, presb[r][jp].y));
                const f32x4 yv = YF8_ ? unpack_f8x4(q ? py[r][jp].y : py[r][jp].x) * F8IS : (q ? L1M_BF2(pyb[r][jp].z, pyb[r][jp].w) : L1M_BF2(pyb[r][jp].x, pyb[r][jp].y));
                const f32x4 g1 = *(const f32x4*)(mv + 2 * DM + e);
                u[r][jp][q] = DN_ALPHA * rv + (1.f + g1) * yv; s += hsum4(u[r][jp][q]); }
            mean[r] = wave_sum(s) * (1.f / DM); } }
        if (g + 1 < ngrp) L1M_LOADG(g + 1);
#pragma unroll
        for (int r = 0; r < 2; ++r) {
            const int tr = 2 * wave + r, m = row0 + 16 * g + tr; const int b = m / SEQ; const float* mv = modv_l + (size_t)b * 6 * DM;
            float s2 = 0.f;
#pragma unroll
            for (int jp = 0; jp < 2; ++jp)
#pragma unroll
                for (int q = 0; q < 2; ++q) { u[r][jp][q] = u[r][jp][q] - mean[r]; s2 += hsum4(u[r][jp][q] * u[r][jp][q]); }
            rs[r] = 1.f / sqrtf(wave_sum(s2) * (1.f / DM) + LN_EPS);
#pragma unroll
            for (int jp = 0; jp < 2; ++jp) { const int e0 = 8 * lane + 512 * jp; unsigned xw[4], hw[4], lw[4];
#pragma unroll
                for (int q = 0; q < 2; ++q) { const int e = e0 + 4 * q;
                    const f32x4 x1 = u[r][jp][q] * rs[r] * *(const f32x4*)(lng + e) + *(const f32x4*)(lnb + e);
                    xw[2 * q] = cvt_pk_bf16(x1[0], x1[1]); xw[2 * q + 1] = cvt_pk_bf16(x1[2], x1[3]);
                    const f32x4 sh = *(const f32x4*)(mv + 3 * DM + e), sc = *(const f32x4*)(mv + 4 * DM + e);
                    const f32x4 hv = x1 * (1.f + sc) + sh;
                    hw[2 * q] = cvt_pk_bf16(hv[0], hv[1]); hw[2 * q + 1] = cvt_pk_bf16(hv[2], hv[3]);
                    lw[2 * q] = cvt_pk_bf16(hv[0] - __uint_as_float(hw[2 * q] << 16), hv[1] - __uint_as_float(hw[2 * q] & 0xffff0000u));
                    lw[2 * q + 1] = cvt_pk_bf16(hv[2] - __uint_as_float(hw[2 * q + 1] << 16), hv[3] - __uint_as_float(hw[2 * q + 1] & 0xffff0000u)); }
                *(pg8::u32x4*)(X1 + (size_t)m * DM + e0) = (pg8::u32x4){xw[0], xw[1], xw[2], xw[3]};
                *(pg8::u32x4*)(H2 + (size_t)m * DM + e0) = (pg8::u32x4){hw[0], hw[1], hw[2], hw[3]};
                *(LAS pg8::u32x4*)(Thi + tr * L1M_TS + e0) = (pg8::u32x4){hw[0], hw[1], hw[2], hw[3]};
                *(LAS pg8::u32x4*)(Tlo + tr * L1M_TS + e0) = (pg8::u32x4){lw[0], lw[1], lw[2], lw[3]}; }
        }
        __syncthreads();
        f32x4 acc[3];
#pragma unroll
        for (int nb = 0; nb < 3; ++nb) acc[nb] = (f32x4){0.f, 0.f, 0.f, 0.f};
#pragma unroll
        for (int ks = 0; ks < 4; ++ks) {
            const bf16x8 Hhi = *(const LAS bf16x8*)(Thi + fr * L1M_TS + 128 * wave + 32 * ks + 8 * fq), Hlo = *(const LAS bf16x8*)(Tlo + fr * L1M_TS + 128 * wave + 32 * ks + 8 * fq);
#pragma unroll
            for (int nb = 0; nb < 3; ++nb) {
                acc[nb] = __builtin_amdgcn_mfma_f32_16x16x32_bf16(Wlo[nb][ks], Hhi, acc[nb], 0, 0, 0);
                acc[nb] = __builtin_amdgcn_mfma_f32_16x16x32_bf16(Whi[nb][ks], Hlo, acc[nb], 0, 0, 0);
                acc[nb] = __builtin_amdgcn_mfma_f32_16x16x32_bf16(Whi[nb][ks], Hhi, acc[nb], 0, 0, 0); }
        }
#pragma unroll
        for (int nb = 0; nb < 3; ++nb) *(LAS f32x4*)(red + (wave * 16 + fr) * 48 + 16 * nb + 4 * fq) = acc[nb];
        __syncthreads();
        for (int i = tid; i < 768; i += NWAVES_LN * 64) { float s = 0.f;
#pragma unroll
            for (int w = 0; w < 8; ++w) s += red[w * 768 + i];
            lgt[g * 768 + i] = s; }
    }
    __syncthreads();
    if (tid < rows_per_blk && !noroute) {
        const int m = row0 + tid; const LAS float* lp = lgt + tid * 48;
        float gmax = lp[0] + b_gr[layer * 4 + 0]; int gi = 0; float gl[4]; gl[0] = gmax;
#pragma unroll
        for (int i = 1; i < 4; ++i) { gl[i] = lp[i] + b_gr[layer * 4 + i]; if (gl[i] > gmax) { gmax = gl[i]; gi = i; } }
        float gs = 0.f;
#pragma unroll
        for (int i = 0; i < 4; ++i) gs += __expf(gl[i] - gmax);
        const float gp = 1.f / gs;
        float v1 = -INFINITY, v2 = -INFINITY; int i1 = 0, i2 = 0;
        for (int i = 0; i < 8; ++i) { const float v = lp[4 + gi * 8 + i] + b_er[layer * 32 + gi * 8 + i];
            if (v > v1) { v2 = v1; i2 = i1; v1 = v; i1 = i; } else if (v > v2) { v2 = v; i2 = i; } }
        const float e2 = __expf(v2 - v1), w1 = gp / (1.f + e2), w2 = gp * e2 / (1.f + e2);
        const int e1i = gi * 8 + i1, e2i = gi * 8 + i2;
        tok_e[2 * m] = e1i; tok_e[2 * m + 1] = e2i; tok_w[2 * m] = w1; tok_w[2 * m + 1] = w2;
        tok_t[2 * m] = (int)__hip_atomic_fetch_add(hist + e1i, 1u, __ATOMIC_RELAXED, __HIP_MEMORY_SCOPE_WORKGROUP); tok_t[2 * m + 1] = (int)__hip_atomic_fetch_add(hist + e2i, 1u, __ATOMIC_RELAXED, __HIP_MEMORY_SCOPE_WORKGROUP);
    }
    __syncthreads();
    if (noroute) return;
    if (tid < 32) { const unsigned n = hist[tid]; hist[32 + tid] = n ? __hip_atomic_fetch_add(cnt + tid, n, __ATOMIC_RELAXED, __HIP_MEMORY_SCOPE_AGENT) : 0u; }
    __syncthreads();
    for (int i = tid; i < rows_per_blk * 2; i += NWAVES_LN * 64) { const int idx = row0 * 2 + i; const int e = tok_e[idx]; const int t = tok_t[idx] + (int)hist[32 + e]; tok_t[idx] = t; list[(size_t)e * M + t] = idx >> 1; }
}
constexpr int LNP_HALO = 15;
__device__ __forceinline__ void rp_ln2pool(LAS unsigned char* lds, int vcu, int G, int lane, int wave, const bf16_t* X1, const unsigned char* Y2, const int* tok_e, const float* tok_w, const int* tok_t, const unsigned* cnt,
                                           const float* modv_l0, const float* lng, const float* lnb, bf16_t* X2, const float* modv_l1, bf16_t* MIX) {
    LAS bf16_t* halo = (LAS bf16_t*)lds;
    const int rows_per_blk = M / G, row0 = vcu * rows_per_blk, b = row0 / SEQ;
    const bool seq_start = (row0 % SEQ) == 0;
    f32x4 lg4[4], lb4[4];
#pragma unroll
    for (int j = 0; j < 4; ++j) { lg4[j] = *(const f32x4*)(lng + 4 * lane + 256 * j); lb4[j] = *(const f32x4*)(lnb + 4 * lane + 256 * j); }
    int mybase; { const int c = (lane < 32) ? (int)cnt[lane] : 0; int pad = (c + 255) & ~255; int incl = pad;
#pragma unroll
        for (int o = 1; o < 32; o <<= 1) { const int t = __shfl_up(incl, o); if ((lane & 31) >= o) incl += t; }
        mybase = incl - pad; }
    {
        const float* mv = modv_l0 + (size_t)b * 6 * DM;
        f32x4 g2[4];
#pragma unroll
        for (int j = 0; j < 4; ++j) g2[j] = 1.f + *(const f32x4*)(mv + 5 * DM + 4 * lane + 256 * j);
        const int rrl = -LNP_HALO + wave + 8 * (lane < 18 ? lane : 17); const bool okl = (rrl < rows_per_blk) && (rrl >= 0 || !seq_start);
        const int ml = okl ? row0 + rrl : row0;
        const int e0 = tok_e[2 * ml], e1 = tok_e[2 * ml + 1]; const float wl0 = tok_w[2 * ml], wl1 = tok_w[2 * ml + 1];
        const int rl0 = __shfl(mybase, e0) + tok_t[2 * ml], rl1 = __shfl(mybase, e1) + tok_t[2 * ml + 1];
#pragma unroll 1
        for (int k = 0; k < 18; k += 2) {
            f32x4 xv[2][4], ya[2][4], yb[2][4]; float w0[2], w1[2]; int rr[2]; bool ok[2];
#pragma unroll
            for (int r = 0; r < 2; ++r) { rr[r] = -LNP_HALO + wave + 8 * (k + r); ok[r] = (rr[r] < rows_per_blk) && (rr[r] >= 0 || !seq_start);
                const size_t r0 = (size_t)__shfl(rl0, k + r), r1 = (size_t)__shfl(rl1, k + r); w0[r] = __shfl(wl0, k + r); w1[r] = __shfl(wl1, k + r);
                if (ok[r]) {
#pragma unroll
                    for (int j = 0; j < 4; ++j) { const int e = 4 * lane + 256 * j; xv[r][j] = ld_bf4(X1 + (size_t)(row0 + rr[r]) * DM + e); ya[r][j] = ld_f8x4(Y2 + r0 * DM + e); yb[r][j] = ld_f8x4(Y2 + r1 * DM + e); } } }
#pragma unroll
            for (int r = 0; r < 2; ++r) if (ok[r]) { f32x4 u[4]; float s = 0.f;
#pragma unroll
                for (int j = 0; j < 4; ++j) { u[j] = DN_ALPHA * xv[r][j] + g2[j] * (w0[r] * ya[r][j] + w1[r] * yb[r][j]); s += hsum4(u[j]); }
                const float mean = wave_sum(s) * (1.f / DM); float s2 = 0.f;
#pragma unroll
                for (int j = 0; j < 4; ++j) { u[j] = u[j] - mean; s2 += hsum4(u[j] * u[j]); }
                const float rs = 1.f / sqrtf(wave_sum(s2) * (1.f / DM) + LN_EPS);
#pragma unroll
                for (int j = 0; j < 4; ++j) { const int e = 4 * lane + 256 * j; const f32x4 o = u[j] * rs * lg4[j] + lb4[j];
                    pg8::u32x2 w; w.x = cvt_pk_bf16(o.x, o.y); w.y = cvt_pk_bf16(o.z, o.w);
                    if (rr[r] >= 0) *(pg8::u32x2*)(X2 + (size_t)(row0 + rr[r]) * DM + e) = w; else *(LAS pg8::u32x2*)(halo + (rr[r] + LNP_HALO) * DM + e) = w; } }
        }
    }
    asm volatile("s_waitcnt vmcnt(0) lgkmcnt(0)" ::: "memory");
    __syncthreads();
    {
        const float* mv = modv_l1 + (size_t)b * 6 * DM;
        const int m0 = row0 + 16 * wave, t0 = m0 % SEQ;
        f32x4 sh[4], sc[4], S[4];
#pragma unroll
        for (int j = 0; j < 4; ++j) { const int e = 4 * lane + 256 * j; sh[j] = *(const f32x4*)(mv + e); sc[j] = 1.f + *(const f32x4*)(mv + DM + e); S[j] = (f32x4){0.f, 0.f, 0.f, 0.f}; }
#define LNP_LD(dst, mrow, e) do { if ((mrow) >= row0) dst = *(const pg8::u32x2*)(X2 + (size_t)(mrow) * DM + (e)); else dst = *(const LAS pg8::u32x2*)(halo + ((mrow) - row0 + LNP_HALO) * DM + (e)); } while (0)
#define LNP_F4(u_) ((f32x4){__uint_as_float((u_).x << 16), __uint_as_float((u_).x & 0xffff0000u), __uint_as_float((u_).y << 16), __uint_as_float((u_).y & 0xffff0000u)})
#pragma unroll
        for (int j = 0; j < 4; ++j) { const int w = 2 << j, e = 4 * lane + 256 * j;
            for (int i = 1; i < w; ++i) if (t0 - i >= 0) { pg8::u32x2 v; LNP_LD(v, m0 - i, e); S[j] += LNP_F4(v) * sc[j] + sh[j]; } }
#pragma unroll 1
        for (int rb = 0; rb < 16; rb += 4) {
            pg8::u32x2 cur[4][4], lag[4][4];
#pragma unroll
            for (int r = 0; r < 4; ++r)
#pragma unroll
                for (int j = 0; j < 4; ++j) { const int w = 2 << j, e = 4 * lane + 256 * j; const int m = m0 + rb + r, t = t0 + rb + r;
                    cur[r][j] = *(const pg8::u32x2*)(X2 + (size_t)m * DM + e);
                    if (t - w + 1 >= 0) LNP_LD(lag[r][j], m - w + 1, e); else lag[r][j] = (pg8::u32x2){0u, 0u}; }
#pragma unroll
            for (int r = 0; r < 4; ++r) { const int m = m0 + rb + r, t = t0 + rb + r;
#pragma unroll
                for (int j = 0; j < 4; ++j) { const int w = 2 << j, e = 4 * lane + 256 * j;
                    const f32x4 hv = LNP_F4(cur[r][j]) * sc[j] + sh[j]; S[j] += hv;
                    const float inv = 1.f / (float)((t + 1 < w) ? (t + 1) : w);
                    st_bf4(MIX + (size_t)m * DM + e, S[j] * inv - hv);
                    if (t - w + 1 >= 0) S[j] -= LNP_F4(lag[r][j]) * sc[j] + sh[j]; }
            }
        }
#undef LNP_LD
#undef LNP_F4
    }
}
constexpr int PG_STR = 264;
constexpr int PG_LDS_BYTES = 2 * 128 * PG_STR * 2;
#define PG_BF4(u_) ((f32x4){__uint_as_float((u_).x << 16), __uint_as_float((u_).x & 0xffff0000u), __uint_as_float((u_).y << 16), __uint_as_float((u_).y & 0xffff0000u)})
template <int GI>
__device__ __forceinline__ void pg_load_rows(const bf16_t* X2, int m0, int t0, int lane, pg8::u32x2 (&cur)[16], pg8::u32x2 (&lag)[15]) {
    constexpr int w = 2 << GI; const int e = 256 * GI + 4 * lane;
#pragma unroll
    for (int r = 0; r < 16; ++r) cur[r] = *(const pg8::u32x2*)(X2 + (size_t)(m0 + r) * DM + e);
#pragma unroll
    for (int r = 0; r < w - 1; ++r) lag[r] = (t0 + r - w + 1 >= 0) ? *(const pg8::u32x2*)(X2 + (size_t)(m0 + r - w + 1) * DM + e) : (pg8::u32x2){0u, 0u};
}
template <int GI>
__device__ __forceinline__ void pg_pool(const float* mv, int t0, int lane, int wave, const pg8::u32x2 (&cur)[16], const pg8::u32x2 (&lag)[15], LAS bf16_t* MIXL) {
    constexpr int w = 2 << GI; const int e = 256 * GI + 4 * lane;
    const f32x4 sh = *(const f32x4*)(mv + e), sc = 1.f + *(const f32x4*)(mv + DM + e);
    f32x4 S = (f32x4){0.f, 0.f, 0.f, 0.f};
#pragma unroll
    for (int r = 0; r < w - 1; ++r) if (t0 + r - w + 1 >= 0) S += PG_BF4(lag[r]) * sc + sh;
#pragma unroll
    for (int r = 0; r < 16; ++r) { const f32x4 hv = PG_BF4(cur[r]) * sc + sh; S += hv; const int t = t0 + r;
        const float inv = 1.f / (float)((t + 1 < w) ? (t + 1) : w); const f32x4 mx = S * inv - hv;
        pg8::u32x2 o; o.x = cvt_pk_bf16(mx[0], mx[1]); o.y = cvt_pk_bf16(mx[2], mx[3]);
        *(LAS pg8::u32x2*)(MIXL + (16 * wave + r) * PG_STR + 4 * lane) = o;
        if (r >= w - 1) S -= PG_BF4(cur[r - w + 1 < 0 ? 0 : r - w + 1]) * sc + sh; else if (t - w + 1 >= 0) S -= PG_BF4(lag[r]) * sc + sh; }
}
template <bool OUTF8>
__device__ __forceinline__ void rp_poolgemm(LAS unsigned char* lds, int vcu, int G, const bf16_t* X2, const float* modv_l1, const bf16_t* WP, const float* pool_scale, bf16_t* YP) {
    typedef short bf16x8 __attribute__((ext_vector_type(8)));
    const int tid = threadIdx.x, lane = tid & 63, wave = __builtin_amdgcn_readfirstlane(tid >> 6), fr = lane & 15, fq = lane >> 4, wm = wave & 3, wn = wave >> 2;
    LAS bf16_t* MIXL = (LAS bf16_t*)lds; LAS bf16_t* WL = MIXL + 128 * PG_STR;
    const int row0 = vcu * (M / G), b = row0 / SEQ, m0 = row0 + 16 * wave, t0 = m0 % SEQ; const float* mv = modv_l1 + (size_t)b * 6 * DM;
    pg8::u32x2 cur[16], lag[15]; pg8::u32x4 wreg[8];
#define PG_LOADW(gg, hh) do { _Pragma("unroll") for (int i = 0; i < 8; ++i) { const int c_ = tid + 512 * i; wreg[i] = *(const pg8::u32x4*)(WP + ((size_t)((gg) * 256 + 128 * (hh) + (c_ >> 5)) * 256 + (c_ & 31) * 8)); } } while (0)
#define PG_STOREW() do { _Pragma("unroll") for (int i = 0; i < 8; ++i) { const int c_ = tid + 512 * i; *(LAS pg8::u32x4*)(WL + (c_ >> 5) * PG_STR + (c_ & 31) * 8) = wreg[i]; } } while (0)
#define PG_GEMM(gg, hh) do { f32x4 acc[2][4]; \
        _Pragma("unroll") for (int mb = 0; mb < 2; ++mb) _Pragma("unroll") for (int nb = 0; nb < 4; ++nb) acc[mb][nb] = (f32x4){0.f, 0.f, 0.f, 0.f}; \
        _Pragma("unroll") for (int ks = 0; ks < 8; ++ks) { bf16x8 bm[2], aw[4]; \
            _Pragma("unroll") for (int mb = 0; mb < 2; ++mb) bm[mb] = *(const LAS bf16x8*)(MIXL + (32 * wm + 16 * mb + fr) * PG_STR + 32 * ks + 8 * fq); \
            _Pragma("unroll") for (int nb = 0; nb < 4; ++nb) aw[nb] = *(const LAS bf16x8*)(WL + (64 * wn + 16 * nb + fr) * PG_STR + 32 * ks + 8 * fq); \
            _Pragma("unroll") for (int mb = 0; mb < 2; ++mb) _Pragma("unroll") for (int nb = 0; nb < 4; ++nb) acc[mb][nb] = __builtin_amdgcn_mfma_f32_16x16x32_bf16(aw[nb], bm[mb], acc[mb][nb], 0, 0, 0); } \
        _Pragma("unroll") for (int nb = 0; nb < 4; ++nb) { const int col = 256 * (gg) + 128 * (hh) + 64 * wn + 16 * nb + 4 * fq; const f32x4 ps = *(const f32x4*)(pool_scale + col); \
            if (OUTF8) { _Pragma("unroll") for (int mb = 0; mb < 2; ++mb) { const f32x4 v = acc[mb][nb] * ps; \
                *(unsigned*)((unsigned char*)YP + (size_t)(row0 + 32 * wm + 16 * mb + fr) * DM + col) = pack_f8x4(v[0] * F8S, v[1] * F8S, v[2] * F8S, v[3] * F8S); } } \
            else { const f32x4 va_ = acc[0][nb] * ps, vb2_ = acc[1][nb] * ps; unsigned xA = cvt_pk_bf16(va_[0], va_[1]), yA = cvt_pk_bf16(va_[2], va_[3]), xB = cvt_pk_bf16(vb2_[0], vb2_[1]), yB = cvt_pk_bf16(vb2_[2], vb2_[3]); \
                { auto r_ = __builtin_amdgcn_permlane16_swap(xA, xB, false, false); xA = r_[0]; xB = r_[1]; } { auto r_ = __builtin_amdgcn_permlane16_swap(yA, yB, false, false); yA = r_[0]; yB = r_[1]; } \
                *(pg8::u32x4*)(YP + (size_t)(row0 + 32 * wm + 16 * (fq & 1) + fr) * DM + col - ((fq & 1) ? 4 : 0)) = (pg8::u32x4){xA, yA, xB, yB}; } } } while (0)
#define PG_GROUP(gg, NEXTLOAD) do { pg_pool<gg>(mv, t0, lane, wave, cur, lag, MIXL); NEXTLOAD; \
        PG_STOREW(); PG_LOADW(gg, 1); __syncthreads(); PG_GEMM(gg, 0); __syncthreads(); \
        PG_STOREW(); if ((gg) < 3) PG_LOADW((gg) + 1, 0); __syncthreads(); PG_GEMM(gg, 1); __syncthreads(); } while (0)
    pg_load_rows<0>(X2, m0, t0, lane, cur, lag); PG_LOADW(0, 0);
    PG_GROUP(0, pg_load_rows<1>(X2, m0, t0, lane, cur, lag));
    PG_GROUP(1, pg_load_rows<2>(X2, m0, t0, lane, cur, lag));
    PG_GROUP(2, pg_load_rows<3>(X2, m0, t0, lane, cur, lag));
    PG_GROUP(3, (void)0);
#undef PG_LOADW
#undef PG_STOREW
#undef PG_GEMM
#undef PG_GROUP
}
#undef PG_BF4
template <int MAP>
__device__ __forceinline__ void conv_item(const float* W, int ldw, int K, bf16_t* WT, const float* kscale, LAS float* scr, int kb, int nb, int lane) {
    const int k0 = 64 * kb, n0 = 32 * nb;
    float v[32];
#pragma unroll
    for (int i = 0; i < 32; ++i) { const int kk = 2 * i + (lane >> 5); v[i] = W[(size_t)(k0 + kk) * ldw + n0 + (lane & 31)]; }
    if (kscale) {
#pragma unroll
        for (int i = 0; i < 32; ++i) v[i] *= kscale[k0 + 2 * i + (lane >> 5)]; }
#pragma unroll
    for (int i = 0; i < 32; ++i) scr[(2 * i + (lane >> 5)) * 33 + (lane & 31)] = v[i];
    asm volatile("s_waitcnt lgkmcnt(0)" ::: "memory");
    const int c = lane & 7;
#pragma unroll
    for (int j = 0; j < 4; ++j) { const int n = (lane >> 3) + 8 * j; const LAS float* s = scr + (8 * c) * 33 + n;
        int row;
        if (MAP == 0) row = n0 + n;
        else if (MAP == 1) { const int p = ((nb % 3) == 2) ? (8 * ((n & 15) >> 2) + 4 * (n >> 4) + (n & 3)) : n; row = n0 + p; }
        else if (MAP == 4) { const int p = (nb == 20) ? (8 * ((n & 15) >> 2) + 4 * (n >> 4) + (n & 3)) : n; row = n0 + p; }
        else { const int jj = n0 + n; row = (jj >> 2) * 8 + (jj & 3) + (MAP == 3 ? 4 : 0); }
        pg8::u32x4 o; o.x = cvt_pk_bf16(s[0 * 33], s[1 * 33]); o.y = cvt_pk_bf16(s[2 * 33], s[3 * 33]); o.z = cvt_pk_bf16(s[4 * 33], s[5 * 33]); o.w = cvt_pk_bf16(s[6 * 33], s[7 * 33]);
        *(pg8::u32x4*)(WT + (size_t)row * K + k0 + 8 * c) = o; }
    asm volatile("s_waitcnt lgkmcnt(0)" ::: "memory");
}

template <int MAP>
__device__ __forceinline__ void conv_item64(const float* W, int ldw, int K, bf16_t* WT, LAS float* scr, int kb, int nb, int lane) {
    const int k0 = 64 * kb, n0 = 64 * nb;
    f32x4 v[16];
    const float* wp = W + (size_t)(k0 + (lane >> 4)) * ldw + n0 + 4 * (lane & 15);
#pragma unroll
    for (int i = 0; i < 16; ++i) v[i] = *(const f32x4*)(wp + (size_t)(4 * i) * ldw);
#pragma unroll
    for (int i = 0; i < 16; ++i) { LAS float* sp = scr + (4 * i + (lane >> 4)) * 65 + 4 * (lane & 15); sp[0] = v[i][0]; sp[1] = v[i][1]; sp[2] = v[i][2]; sp[3] = v[i][3]; }
    asm volatile("s_waitcnt lgkmcnt(0)" ::: "memory");
    const int c = lane & 7;
#pragma unroll
    for (int j = 0; j < 8; ++j) { const int n = (lane >> 3) + 8 * j; const LAS float* s = scr + (8 * c) * 65 + n;
        int row; if (MAP == 0) row = n0 + n; else { const int jj = n0 + n; row = (jj >> 2) * 8 + (jj & 3) + (MAP == 3 ? 4 : 0); }
        pg8::u32x4 o; o.x = cvt_pk_bf16(s[0 * 65], s[1 * 65]); o.y = cvt_pk_bf16(s[2 * 65], s[3 * 65]); o.z = cvt_pk_bf16(s[4 * 65], s[5 * 65]); o.w = cvt_pk_bf16(s[6 * 65], s[7 * 65]);
        *(pg8::u32x4*)(WT + (size_t)row * K + k0 + 8 * c) = o; }
    asm volatile("s_waitcnt lgkmcnt(0)" ::: "memory");
}

struct Args { const void* in[22]; float* out; unsigned char* ws; int ph_lo, ph_hi, variant, pad; };
constexpr int NPHASE = 17;
#ifndef MK_THRL
#define MK_THRL -1
#endif
#ifndef MK_FILL_PCT
#define MK_FILL_PCT 100
#endif
#ifndef MK_YF8
#define MK_YF8 0
#endif
constexpr bool YF8 = (MK_YF8 & 1) != 0, YPF8 = (MK_YF8 & 2) != 0;

__global__ void __launch_bounds__(NWAVES * 64, 2) mk_fwd(Args args) {
    extern __shared__ __attribute__((aligned(16))) unsigned char lds_dyn[];
    LAS unsigned char* lds = (LAS unsigned char*)lds_dyn;
    const int tid = threadIdx.x, lane = tid & 63, wave = __builtin_amdgcn_readfirstlane(tid >> 6);
    const int G = gridDim.x; const int bx = blockIdx.x; const int vcu = (G % 8 == 0) ? (bx % 8) * (G / 8) + bx / 8 : bx;
    volatile LAS unsigned* MISC = (volatile LAS unsigned*)(lds + MISC_OFF);
    if (tid < 64) MISC[tid] = 0u;
    __syncthreads();
#define KA_ ((const __attribute__((address_space(4))) char*)__builtin_amdgcn_kernarg_segment_ptr())
#define ARGQ(i) (*(const __attribute__((address_space(4))) unsigned long long volatile*)(KA_ + 8 * (i)))
#define INP(T, i) ((const T*)(const __attribute__((address_space(1))) T*)ARGQ(i))
#define WSB(T, off) ((T*)(__attribute__((address_space(1))) T*)(ARGQ(23) + (unsigned long long)(off)))
#define x INP(float, 0)
#define c_in INP(float, 1)
#define positions INP(int, 2)
#define w_mod INP(float, 3)
#define b_mod INP(float, 4)
#define ln_g INP(float, 5)
#define ln_b INP(float, 6)
#define w_in INP(float, 7)
#define q_norm_g INP(float, 8)
#define kv_norm_g INP(float, 9)
#define w_uq INP(float, 10)
#define w_ukv INP(float, 11)
#define w_o INP(float, 12)
#define w_pool INP(float, 13)
#define pool_scale INP(float, 14)
#define w_gr INP(float, 15)
#define b_gr INP(float, 16)
#define w_er INP(float, 17)
#define b_er INP(float, 18)
#define w_gate INP(float, 19)
#define w_up INP(float, 20)
#define w_down INP(float, 21)
#define OUTPTR ((float*)(__attribute__((address_space(1))) float*)ARGQ(22))
#define ctl WSB(unsigned, WS_CTL)
#define modv WSB(float, WS_MODV)
#define modv0 WSB(float, WS_MODV)
#define modv1 WSB(float, WS_MODV + 8 * 6 * DM * 4)
#define WGU WSB(bf16_t, WS_WGU)
#define WD WSB(bf16_t, WS_WD)
#define WIN WSB(bf16_t, WS_WIN)
#define WUQ WSB(bf16_t, WS_WUQ)
#define WUKV WSB(bf16_t, WS_WUKV)
#define WO WSB(bf16_t, WS_WO)
#define WPOOL WSB(bf16_t, WS_WPOOL)
#define tok_e WSB(int, WS_TOK)
#define tok_w WSB(float, WS_TOK + 256 * 1024)
#define tok_t WSB(int, WS_TOK + 512 * 1024)
#define rstd WSB(float, WS_RSTD)
#define X1 WSB(bf16_t, WS_X1)
#define H2 WSB(bf16_t, WS_H2)
#define KVB WSB(bf16_t, WS_KVB)
#define Qb WSB(bf16_t, WS_Q)
#define HE WSB(bf16_t, WS_HE)
#define X2 WSB(bf16_t, WS_X2)
#define Ob WSB(bf16_t, WS_O)
#define Y2 WSB(bf16_t, WS_Y2)
#define Zb WSB(bf16_t, WS_Z)
#define Yb WSB(bf16_t, WS_Y)
#define H0 WSB(bf16_t, WS_H0)
#define KR WSB(bf16_t, WS_KR)
#define list WSB(int, WS_LIST)
#define CS WSB(float, WS_CS)
#define SSQB WSB(float, WS_SSQ)
#define MIX H2
#define YP Y2
#define X3 X1
    RowCtx R{lane, wave, vcu * NWAVES + wave, G * NWAVES};

    XcdBarrier bar = xcd_barrier_post(ctl + CW_BAR, MISC + 8);
    const int lo = args.ph_lo, hi = args.ph_hi;
#ifndef MK_CMASK
#define MK_CMASK 0x1FFFF
#endif
#define IN(k) (((MK_CMASK >> (k)) & 1) && lo <= (k) && (k) < hi)
#ifndef MK_DBLMASK
#define MK_DBLMASK 0
#endif
#define PH_REP(k) ((((MK_DBLMASK) >> (k)) & 1) ? 2 : 1)
#define INR(k) if (IN(k))
#ifndef MK_DBLBAR
#define MK_DBLBAR 0
#endif
#define SEAM(k) do { if (IN(k) && IN((k) + 1)) { xcd_barrier(bar); if (MK_DBLBAR) xcd_barrier(bar); } } while (0)

    INR(0) {
        if (bx < 192) {
            const int l = bx / 96, cg = bx % 96;
            LAS float* cact = (LAS float*)lds; LAS float* red = (LAS float*)(lds + 32768);
            for (int i = tid; i < 8 * DM; i += NWAVES * 64) { const float cv = c_in[i]; cact[i] = cv / (1.f + __expf(-cv)); }
            __syncthreads();
            float acc[8];
#pragma unroll
            for (int b = 0; b < 8; ++b) acc[b] = 0.f;
            const float* wp = w_mod + ((size_t)l * DM + wave * 128) * 6144 + 64 * cg + lane;
#pragma unroll 1
            for (int k0 = 0; k0 < 128; k0 += 16) { float wv[16];
#pragma unroll
                for (int k = 0; k < 16; ++k) wv[k] = wp[(size_t)(k0 + k) * 6144];
#pragma unroll
                for (int k = 0; k < 16; ++k)
#pragma unroll
                    for (int b = 0; b < 8; ++b) acc[b] += cact[b * DM + wave * 128 + k0 + k] * wv[k]; }
#pragma unroll
            for (int b = 0; b < 8; ++b) red[(wave * 8 + b) * 64 + lane] = acc[b];
            __syncthreads();
            { const int b = tid >> 6, col = tid & 63; float s = b_mod[l * 6144 + 64 * cg + col];
#pragma unroll
              for (int w = 0; w < 8; ++w) s += red[(w * 8 + b) * 64 + col];
              modv[((size_t)l * 8 + b) * 6144 + 64 * cg + col] = s; }
            __syncthreads();
        }
        {
            pg8::u32x4* z = (pg8::u32x4*)(WIN + (size_t)ZW * DM); const int n16 = (ZP - ZW) * DM * 2 / 16;
            for (int i = bx * 512 + tid; i < n16; i += G * 512) z[i] = (pg8::u32x4){0u, 0u, 0u, 0u};
        }
        LAS float* scr = (LAS float*)(lds + wave * 8448);
        constexpr int I0 = 16 * 21, I1 = 6 * 48, I2 = 4 * 64, I3 = 16 * 32, I4 = 4 * 32;
        constexpr int NITEMS = I0 + I1 + I2 + I3 + I4;
        for (int it = R.gw; it < NITEMS; it += R.ngw) {
            int r = it;
            if (r < I0) { conv_item<4>(w_in, ZW, DM, WIN, nullptr, scr, r / 21, r % 21, lane); continue; } r -= I0;
            if (r < I1) { conv_item<0>(w_uq, NQ, QLR, WUQ, q_norm_g, scr, r / 48, r % 48, lane); continue; } r -= I1;
            if (r < I2) { conv_item<0>(w_ukv, NKV, KVLR, WUKV, kv_norm_g, scr, r / 64, r % 64, lane); continue; } r -= I2;
            if (r < I3) { conv_item<0>(w_o, DM, DM, WO, nullptr, scr, r / 32, r % 32, lane); continue; } r -= I3;
            { const int g = r / 32, q = r % 32; conv_item<0>(w_pool + (size_t)g * 65536, 256, 256, WPOOL + (size_t)g * 65536, nullptr, scr, q / 8, q % 8, lane); }
        }
    }
    SEAM(0);
#define MOE_WEIGHT_FILLER(L, RANK, NIDLE) MOE_WEIGHT_FILLER_R(L, RANK, NIDLE, 0, 3 * 32 * 64)
#define MOE_WEIGHT_FILLER_R(L, RANK, NIDLE, LO, HI) do { LAS float* scr_ = (LAS float*)(lds + wave * 16640); \
        if ((RANK) >= 0) for (int it_ = (LO) + (RANK) * NWAVES + wave; it_ < (HI); it_ += (NIDLE) * NWAVES) { \
            const int kind_ = it_ / 2048, r_ = it_ % 2048, le_ = (L) * 32 + r_ / 64, q2_ = r_ % 64; \
            if (kind_ == 0) conv_item64<2>(w_gate + (size_t)le_ * DM * FF, FF, DM, WGU + (size_t)le_ * 512 * DM, scr_, q2_ / 4, q2_ % 4, lane); \
            else if (kind_ == 1) conv_item64<3>(w_up + (size_t)le_ * DM * FF, FF, DM, WGU + (size_t)le_ * 512 * DM, scr_, q2_ / 4, q2_ % 4, lane); \
            else conv_item64<0>(w_down + (size_t)le_ * FF * DM, DM, FF, WD + (size_t)le_ * DM * FF, scr_, q2_ / 16, q2_ % 16, lane); } } while (0)
    INR(1) rp_h0(R, x, modv0, H0, positions, CS);
    SEAM(1);
    INR(2) { pg8::StaticOrderT<ZP / 256> S; S.init(H0, DM, WIN, DM, M, ZP, G, bx); pg8::EpiZ E{Zb, SSQB, KR, CS};
        pg8::gemm_phase<pg8::EpiZ, pg8::StaticOrderT<ZP / 256>, true>(lds + RING_OFF, DM, DM, S, E);
        { const int nbusy = (M / 256) * (ZP / 256) - G;
          constexpr int NSPLIT = (3 * 32 * 64 * MK_FILL_PCT / 100) & ~7;
          if (nbusy > 0 && nbusy < G) { if (bx >= nbusy) MOE_WEIGHT_FILLER_R(0, bx - nbusy, G - nbusy, 0, NSPLIT); else MOE_WEIGHT_FILLER_R(0, bx, nbusy, NSPLIT, 3 * 32 * 64); } else MOE_WEIGHT_FILLER(0, bx, G); } }
    SEAM(2);
    INR(4) {
#define P4_RS(S, off, n, inv) do { LAS float* rs_ = (LAS float*)(lds + ROWTAB_OFF); pg8::Unit u_; const float* sq_ = SSQB; \
          for (int i_ = 0; i_ < 4; ++i_) { if (!S.next(i_, u_)) break; if (tid < 256) { const float* p_ = sq_ + (size_t)(u_.pm * 256 + tid) * 24 + (off); float s_ = hsum4(*(const f32x4*)p_) + hsum4(*(const f32x4*)(p_ + 4)); if ((n) == 12) s_ += hsum4(*(const f32x4*)(p_ + 8)); \
              rs_[i_ * 256 + tid] = 1.f / sqrtf(s_ * (inv) + RMS_EPS); } } __syncthreads(); } while (0)
#define P4_QG() do { pg8::StaticOrderT<NQ / 256> S; S.init(Zb, ZP, WUQ, QLR, M, NQ, G, bx); P4_RS(S, 0, 12, 1.f / QLR); pg8::EpiStore<false, true> E{Qb, QP, nullptr, 0, QSCALE * F8S, nullptr, nullptr, args.variant, nullptr, 0, 0, 0.f, (const LAS float*)(lds + ROWTAB_OFF)};     \
          pg8::gemm_phase<pg8::EpiStore<false, true>, pg8::StaticOrderT<NQ / 256>, true>(lds + RING_OFF, QLR, QLR, S, E); } while (0)
#define P4_KVG() do { pg8::StaticOrderT<NKV / 256> S; S.init(Zb + QLR, ZP, WUKV, KVLR, M, NKV, G, bx); P4_RS(S, 12, 8, 1.f / KVLR); pg8::EpiStore<false> E{KVB, KVP, nullptr, 0, 1.f, nullptr, nullptr, args.variant, nullptr, 0, 0, 0.f, (const LAS float*)(lds + ROWTAB_OFF)}; \
          pg8::gemm_phase<pg8::EpiStore<false>, pg8::StaticOrderT<NKV / 256>, true>(lds + RING_OFF, KVLR, KVLR, S, E); } while (0)
        if (vcu & 1) { P4_KVG(); P4_QG(); } else { P4_QG(); P4_KVG(); }
#undef P4_QG
#undef P4_RS
#undef P4_KVG
    }
    SEAM(4);
    INR(5) attn::attn_phase<MK_THRL>((char*)lds_dyn + RING_OFF, Qb, KVB, KR, CS, Ob, vcu, G);
    SEAM(5);
    INR(6) { pg8::StaticOrderT<DM / 256> S; S.init(Ob, DM, WO, DM, M, DM, G, bx); pg8::EpiStore<false, YF8> E{Yb, DM, nullptr, 0, YF8 ? F8S : 1.f, nullptr, nullptr};
        pg8::gemm_phase<pg8::EpiStore<false, YF8>, pg8::StaticOrderT<DM / 256>, true>(lds + RING_OFF, DM, DM, S, E); }
    SEAM(6);
#define MOE_LAYER(P, L, RESF32, RES, YBR, XA, XOUT, OUTF32) \
    INR(P) rp_ln1m<RESF32, ((L) == 0 ? YF8 : YPF8)>(lds, L, RES, YBR, modv + (size_t)(L) * 8 * 6 * DM, ln_g + (size_t)(L) * 2 * DM, ln_b + (size_t)(L) * 2 * DM, w_gr, b_gr, w_er, b_er, XA, H2, tok_e, tok_w, tok_t, ctl + CW_CNT + 64 * (L), list, args.variant); \
    SEAM(P); \
    INR((P) + 1) { moe_gemm<true>(lds, L, G, vcu, ctl + CW_CNT + 64 * (L), list, H2, WGU, HE, Y2); if ((L) == 0) { const LAS int* tb_ = (const LAS int*)(lds + TB_OFF); const int nu_ = 2 * tb_[32], nb_ = nu_ % G;     \
          if (nb_ > 0) MOE_WEIGHT_FILLER(1, vcu - nb_, G - nb_); else MOE_WEIGHT_FILLER(1, vcu, G); } } \
    SEAM((P) + 1); \
    INR((P) + 2) moe_gemm<false>(lds, L, G, vcu, ctl + CW_CNT + 64 * (L), list, HE, WD, HE, Y2, args.variant); \
    SEAM((P) + 2); \
    INR((P) + 3) rp_ln2<OUTF32, true, true>(R, XA, Y2, tok_e, tok_w, tok_t, ctl + CW_CNT + 64 * (L), modv + (size_t)(L) * 8 * 6 * DM, ln_g + (size_t)(L) * 2 * DM + DM, ln_b + (size_t)(L) * 2 * DM + DM, XOUT);
#ifndef MK_FUSE_PG
#define MK_FUSE_PG 1
#endif
#ifndef MK_FUSE_POOL
#define MK_FUSE_POOL 0
#endif
#if MK_FUSE_POOL
    INR(7) rp_ln1m<true, YF8>(lds, 0, x, Yb, modv, ln_g, ln_b, w_gr, b_gr, w_er, b_er, X1, H2, tok_e, tok_w, tok_t, ctl + CW_CNT, list, args.variant);
    SEAM(7);
    INR(8) { moe_gemm<true>(lds, 0, G, vcu, ctl + CW_CNT, list, H2, WGU, HE, Y2); { const LAS int* tb_ = (const LAS int*)(lds + TB_OFF); const int nu_ = 2 * tb_[32], nb_ = nu_ % G;
          if (nb_ > 0) MOE_WEIGHT_FILLER(1, vcu - nb_, G - nb_); else MOE_WEIGHT_FILLER(1, vcu, G); } }
    SEAM(8);
    INR(9) moe_gemm<false>(lds, 0, G, vcu, ctl + CW_CNT, list, HE, WD, HE, Y2, args.variant);
    SEAM(9);
    INR(10) rp_ln2pool(lds, vcu, G, lane, wave, X1, (const unsigned char*)Y2, tok_e, tok_w, tok_t, ctl + CW_CNT, modv, ln_g + DM, ln_b + DM, X2, modv1, MIX);
    SEAM(10);
#else
    MOE_LAYER(7, 0, true, x, Yb, X1, X2, false)
    SEAM(10);
#if MK_FUSE_PG
    INR(11) rp_poolgemm<YPF8>(lds, vcu, G, X2, modv1, WPOOL, pool_scale, YP);
#else
    INR(11) rp_pool(R, X2, modv1, MIX);
    SEAM(11);
#endif
#endif
#if !MK_FUSE_PG
    INR(12) { pg8::BlockDiagOrder S; S.init(MIX, DM, WPOOL, M, G, bx); pg8::EpiStore<false, YPF8> E{YP, DM, nullptr, 0, YPF8 ? F8S : 1.f, pool_scale, nullptr};
        pg8::gemm_phase<pg8::EpiStore<false, YPF8>, pg8::BlockDiagOrder, true>(lds + RING_OFF, 256, 256, S, E); }
#endif
#if MK_FUSE_PG
    if (IN(11) && IN(13)) { asm volatile("s_waitcnt vmcnt(0)" ::: "memory"); __syncthreads(); }
#else
    SEAM(12);
#endif
    MOE_LAYER(13, 1, false, X2, YP, X3, OUTPTR, true)
#undef IN
#undef SEAM
#undef SSQB
#undef x
#undef c_in
#undef positions
#undef w_mod
#undef b_mod
#undef ln_g
#undef ln_b
#undef w_in
#undef q_norm_g
#undef kv_norm_g
#undef w_uq
#undef w_ukv
#undef w_o
#undef w_pool
#undef pool_scale
#undef w_gr
#undef b_gr
#undef w_er
#undef b_er
#undef w_gate
#undef w_up
#undef w_down
#undef OUTPTR
#undef ctl
#undef modv
#undef modv0
#undef modv1
#undef WGU
#undef WD
#undef WIN
#undef WUQ
#undef WUKV
#undef WO
#undef WPOOL
#undef tok_e
#undef tok_w
#undef tok_t
#undef rstd
#undef X1
#undef H2
#undef KVB
#undef Qb
#undef HE
#undef X2
#undef Ob
#undef Y2
#undef Zb
#undef Yb
#undef H0
#undef KR
#undef list
#undef CS
#undef MIX
#undef YP
#undef X3
#undef KA_
#undef ARGQ
#undef INP
#undef WSB
}
#ifndef MK_ONE_LAUNCH
#define MK_ONE_LAUNCH 0
#endif
#ifndef MK_FASTMASK
#define MK_FASTMASK 0x1FFFF
#endif
extern "C" void kernel_launch(void* const* d_in, const int* in_sizes, int n_in, void* d_out, int out_size, void* d_ws, size_t ws_size, hipStream_t stream) {
    static int grid = 0;
    if (grid == 0) {
        if (n_in != 22 || in_sizes[0] != M * DM || out_size != M * DM || ws_size < WS_END) { fprintf(stderr, "kernel_launch: unexpected sizes n_in %d in0 %d out %d ws %zu\n", n_in, n_in > 0 ? in_sizes[0] : -1, out_size, ws_size); grid = -1; return; }
        (void)hipFuncSetAttribute((const void*)rk_ln1<true, false>, hipFuncAttributeMaxDynamicSharedMemorySize, LN1_LDS_BYTES);
        (void)hipFuncSetAttribute((const void*)rk_ln1<false, false>, hipFuncAttributeMaxDynamicSharedMemorySize, LN1_LDS_BYTES);
        if (hipFuncSetAttribute((const void*)mk_fwd, hipFuncAttributeMaxDynamicSharedMemorySize, LDS_BYTES) != hipSuccess) { fprintf(stderr, "kernel_launch: hipFuncSetAttribute(mk_fwd, %d) failed\n", LDS_BYTES); grid = -1; return; }
        int dev = 0, cus = 0, per_cu = 0;
        if (hipGetDevice(&dev) != hipSuccess || hipDeviceGetAttribute(&cus, hipDeviceAttributeMultiprocessorCount, dev) != hipSuccess) { grid = -1; return; }
        if (hipOccupancyMaxActiveBlocksPerMultiprocessor(&per_cu, (const void*)mk_fwd, NWAVES * 64, LDS_BYTES) != hipSuccess || per_cu < 1) fprintf(stderr, "kernel_launch: occupancy query reports %d\n", per_cu);
        (void)hipGetLastError();
        grid = cus;
        if (grid != 256) fprintf(stderr, "kernel_launch: %d CUs (built for 256)\n", grid);
    }
    if (grid < 0) return;
    const float* x = (const float*)d_in[0]; const float* c = (const float*)d_in[1]; const int* positions = (const int*)d_in[2];
    const float* w_mod = (const float*)d_in[3]; const float* b_mod = (const float*)d_in[4]; const float* ln_g = (const float*)d_in[5]; const float* ln_b = (const float*)d_in[6];
    const float* w_in = (const float*)d_in[7]; const float* q_norm_g = (const float*)d_in[8]; const float* kv_norm_g = (const float*)d_in[9];
    const float* w_uq = (const float*)d_in[10]; const float* w_ukv = (const float*)d_in[11]; const float* w_o = (const float*)d_in[12];
    const float* w_pool = (const float*)d_in[13]; const float* pool_scale = (const float*)d_in[14];
    const float* w_gr = (const float*)d_in[15]; const float* b_gr = (const float*)d_in[16]; const float* w_er = (const float*)d_in[17]; const float* b_er = (const float*)d_in[18];
    const float* w_gate = (const float*)d_in[19]; const float* w_up = (const float*)d_in[20]; const float* w_down = (const float*)d_in[21];
    unsigned char* ws = (unsigned char*)d_ws;
    unsigned* ctl = (unsigned*)(ws + WS_CTL); float* modv = (float*)(ws + WS_MODV);
    int* tok_e = (int*)(ws + WS_TOK); float* tok_w = (float*)(ws + WS_TOK + 256 * 1024); int* tok_t = (int*)(ws + WS_TOK + 512 * 1024);
    float* rstd = (float*)(ws + WS_RSTD); bf16_t* X1 = (bf16_t*)(ws + WS_X1); bf16_t* H2 = (bf16_t*)(ws + WS_H2); bf16_t* KVB = (bf16_t*)(ws + WS_KVB); bf16_t* Qb = (bf16_t*)(ws + WS_Q);
    bf16_t* X2 = (bf16_t*)(ws + WS_X2); bf16_t* Ob = (bf16_t*)(ws + WS_O); bf16_t* Y2 = (bf16_t*)(ws + WS_Y2); bf16_t* Zb = (bf16_t*)(ws + WS_Z); bf16_t* Yb = (bf16_t*)(ws + WS_Y);
    bf16_t* H0 = (bf16_t*)(ws + WS_H0); bf16_t* KR = (bf16_t*)(ws + WS_KR); int* list = (int*)(ws + WS_LIST);
    (void)hipMemsetAsync(ws + WS_CTL, 0, CTL_ZERO_BYTES, stream);
    const float* modv0 = modv; const float* modv1 = modv + 8 * 6 * DM;
    bf16_t* MIX = H2; bf16_t* YP = Y2; bf16_t* X3 = X1;
    Args a{};
    for (int i = 0; i < 22; ++i) a.in[i] = d_in[i];
    a.out = (float*)d_out; a.ws = ws;
    if (MK_ONE_LAUNCH) { a.ph_lo = 0; a.ph_hi = NPHASE; hipLaunchKernelGGL(mk_fwd, dim3(grid), dim3(NWAVES * 64), LDS_BYTES, stream, a); return; }
    const unsigned fm = MK_FASTMASK;
#define FAST(k) ((fm >> (k)) & 1u)
#ifndef MK_VARIANT
#define MK_VARIANT 0
#endif
#ifndef MK_HDBL
#define MK_HDBL 0
#endif
#define RUNF(k) do { a.ph_lo = (k); a.ph_hi = (k) + 1; for (int rep_ = 0; rep_ < ((((MK_HDBL) >> (k)) & 1) ? 2 : 1); ++rep_) { a.variant = rep_ ? MK_VARIANT : 0; hipLaunchKernelGGL(mk_fwd, dim3(grid), dim3(NWAVES * 64), LDS_BYTES, stream, a); } a.variant = 0; } while (0)
    if (FAST(0)) RUNF(0); else nk_mod<<<2 * 8 * 6144 / 256, 256, 0, stream>>>(c, w_mod, b_mod, modv);
    if (FAST(1)) RUNF(1); else rk_h0<<<256, 512, 0, stream>>>(x, modv0, H0);
    if (FAST(2)) RUNF(2); else nk_gemm<EpiPlain><<<dim3(3, M / 8), 256, 0, stream>>>(H0, DM, w_in, ZW, nullptr, DM, ZW, mk_epi(Zb, ZP, nullptr, 0, 1.f, nullptr));
    if (FAST(3)) RUNF(3); else rk_rms<<<256, 512, 0, stream>>>(Zb, positions, rstd, KR, (float*)(ws + WS_CS));
    if (FAST(4)) { RUNF(4); if (!FAST(5)) nk_rope_q<<<M * 256 / 256, 256, 0, stream>>>(Qb, positions); } else {
        nk_gemm<EpiPlain><<<dim3(6, M / 8), 256, 0, stream>>>(Zb, ZP, w_uq, NQ, q_norm_g, QLR, NQ, mk_epi(Qb, QP, rstd, 2, QSCALE, nullptr));
        if (!FAST(5)) nk_rope_q<<<M * 256 / 256, 256, 0, stream>>>(Qb, positions);
        nk_gemm<EpiPlain><<<dim3(8, M / 8), 256, 0, stream>>>(Zb + QLR, ZP, w_ukv, NKV, kv_norm_g, KVLR, NKV, mk_epi(KVB, KVP, rstd + 1, 2, 1.f, nullptr)); }
    if (FAST(5)) RUNF(5); else nk_attn<<<dim3(SEQ / 64, NH, BATCH), 64, 0, stream>>>(Qb, KVB, KR, Ob);
    if (FAST(6)) RUNF(6); else nk_gemm<EpiPlain><<<dim3(4, M / 8), 256, 0, stream>>>(Ob, DM, w_o, DM, nullptr, DM, DM, mk_epi(Yb, DM, nullptr, 0, 1.f, nullptr));
    if (FAST(7)) { RUNF(7); RUNF(8); RUNF(9); RUNF(10); } else {
        rk_ln1<true, false><<<256, 512, LN1_LDS_BYTES, stream>>>(0, x, Yb, modv0, ln_g, ln_b, w_gr, b_gr, w_er, b_er, X1, H2, tok_e, tok_w, tok_t, ctl + CW_CNT, list);
        nk_moe<<<2 * M, 256, 0, stream>>>(H2, tok_e, w_gate, w_up, w_down, Y2);
        rk_ln2<false, false><<<256, 512, 0, stream>>>(X1, Y2, tok_e, tok_w, tok_t, ctl + CW_CNT, modv0, ln_g + DM, ln_b + DM, X2); }
    if (FAST(11)) RUNF(11); else rk_pool<<<256, 512, 0, stream>>>(X2, modv1, MIX);
    if (FAST(12)) RUNF(12); else for (int g = 0; g < 4; ++g)
        nk_gemm<EpiPlain><<<dim3(1, M / 8), 256, 0, stream>>>(MIX + g * 256, DM, w_pool + (size_t)g * 256 * 256, 256, nullptr, 256, 256, mk_epi(YP + g * 256, DM, nullptr, 0, 1.f, pool_scale + g * 256));
    if (FAST(13)) { RUNF(13); RUNF(14); RUNF(15); RUNF(16); } else {
        rk_ln1<false, false><<<256, 512, LN1_LDS_BYTES, stream>>>(1, X2, YP, modv1, ln_g + 2 * DM, ln_b + 2 * DM, w_gr, b_gr, w_er, b_er, X3, H2, tok_e, tok_w, tok_t, ctl + CW_CNT + 64, list);
        nk_moe<<<2 * M, 256, 0, stream>>>(H2, tok_e, w_gate + (size_t)NE * DM * FF, w_up + (size_t)NE * DM * FF, w_down + (size_t)NE * FF * DM, Y2);
        rk_ln2<true, false><<<256, 512, 0, stream>>>(X3, Y2, tok_e, tok_w, tok_t, ctl + CW_CNT + 64, modv1, ln_g + 3 * DM, ln_b + 3 * DM, d_out); }
}
```

```cpp
#define MK_FASTMASK 0x1FFFF
#define MK_ONE_LAUNCH 1
#define MK_YF8 1
#define MK_ZSPLIT 0
#include <hip/hip_runtime.h>
#include <cstdio>
#include <cstdint>

constexpr int BATCH = 8, SEQ = 4096, DM = 1024, M = BATCH * SEQ;
constexpr int NH = 16, QLR = 384, KVLR = 256, DNOPE = 64, DROPE = 32, DV = 64, DQK = 96, ZW = 672, ZP = 768;
constexpr int NQ = NH * DQK  , NKV = NH * (DNOPE + DV)  ;
constexpr int QP = NQ + 64, KVP = NKV + 64;
constexpr int NGRP = 4, EPG = 8, NE = 32, FF = 256, NRT = 36;
constexpr float DN_ALPHA = 1.4142135623730951f, LN_EPS = 1e-5f, RMS_EPS = 1e-6f;
constexpr float QSCALE = 0.14724444602590306f;

constexpr size_t MiB = 1u << 20;
constexpr size_t WS_CTL = 0, CTL_ZERO_BYTES = 32768;
constexpr size_t WS_MODV = 1 * MiB;
constexpr size_t WS_WGU = 2 * MiB;
constexpr size_t WS_WD = 66 * MiB;
constexpr size_t WS_WIN = 98 * MiB;
constexpr size_t WS_WUQ = WS_WIN + 1536 * 1024;
constexpr size_t WS_WUKV = WS_WUQ + 1152 * 1024;
constexpr size_t WS_WO = WS_WUKV + 1 * MiB;
constexpr size_t WS_WPOOL = WS_WO + 2 * MiB;
constexpr size_t WS_TOK = 104 * MiB + 256 * 1024;
constexpr size_t WS_RSTD = 105 * MiB;
constexpr size_t WS_X1 = 106 * MiB;
constexpr size_t WS_H2 = 170 * MiB;
constexpr size_t WS_KVB = 106 * MiB;
constexpr size_t WS_Q = 238 * MiB;
constexpr size_t WS_HE = 234 * MiB;
constexpr size_t WS_X2 = 274 * MiB;
constexpr size_t WS_O = 338 * MiB;
constexpr size_t WS_Y2 = 340 * MiB;
constexpr size_t WS_Z = 394 * MiB;
constexpr size_t WS_Y = 402 * MiB;
constexpr size_t WS_H0 = 442 * MiB;
constexpr size_t WS_CS = 300 * MiB;
constexpr size_t WS_KR = 506 * MiB;
constexpr size_t WS_LIST = 508 * MiB;
constexpr size_t WS_SSQ = 508 * MiB;
constexpr size_t WS_END = 512 * MiB;
constexpr int CW_QA = 512, CW_QB = 576;
constexpr int CW_CNT = 1024;

typedef unsigned short bf16_t;
typedef float f32x4 __attribute__((ext_vector_type(4)));
typedef float f32x2 __attribute__((ext_vector_type(2)));
typedef unsigned pg8_u32x2 __attribute__((ext_vector_type(2)));
typedef unsigned pg8_u32x4 __attribute__((ext_vector_type(4)));
#define LAS __attribute__((address_space(3)))

__device__ __forceinline__ float bf2f(bf16_t v) { return __uint_as_float((unsigned)v << 16); }
__device__ __forceinline__ unsigned cvt_pk_bf16(float lo, float hi) { unsigned r; asm volatile("v_cvt_pk_bf16_f32 %0, %1, %2" : "=v"(r) : "v"(lo), "v"(hi)); return r; }
__device__ __forceinline__ bf16_t f2bf(float f) { return (bf16_t)(cvt_pk_bf16(f, 0.f) & 0xffffu); }
__device__ __forceinline__ f32x4 ld_bf4(const bf16_t* p) { const uint2 u = *(const uint2*)p; return (f32x4){__uint_as_float(u.x << 16), __uint_as_float(u.x & 0xffff0000u), __uint_as_float(u.y << 16), __uint_as_float(u.y & 0xffff0000u)}; }
__device__ __forceinline__ void st_bf4(bf16_t* p, f32x4 v) { uint2 u; u.x = cvt_pk_bf16(v.x, v.y); u.y = cvt_pk_bf16(v.z, v.w); *(uint2*)p = u; }
__device__ __forceinline__ float wave_sum(float v) {
#pragma unroll
    for (int o = 1; o < 64; o <<= 1) v += __shfl_xor(v, o);
    return v;
}
__device__ __forceinline__ float hsum4(f32x4 v) { return (v.x + v.y) + (v.z + v.w); }
constexpr float F8S = 8.f, F8IS = 0.125f;
__device__ __forceinline__ unsigned pack_f8x4(float a, float b, float c, float d) { int v = 0; v = __builtin_amdgcn_cvt_pk_fp8_f32(a, b, v, false); v = __builtin_amdgcn_cvt_pk_fp8_f32(c, d, v, true); return (unsigned)v; }
__device__ __forceinline__ f32x4 unpack_f8x4(unsigned u) { const f32x2 lo = __builtin_amdgcn_cvt_pk_f32_fp8((int)u, false), hi = __builtin_amdgcn_cvt_pk_f32_fp8((int)u, true); return (f32x4){lo.x, lo.y, hi.x, hi.y}; }
__device__ __forceinline__ f32x4 ld_f8x4(const unsigned char* p) { return unpack_f8x4(*(const unsigned*)p) * F8IS; }

__constant__ double ROPE_INV_REV[16] = {0.15915494309189535, 0.08949940160889101, 0.050329212104487035, 0.0283021958306234, 0.015915494309189534, 0.008949940160889102, 0.005032921210448704, 0.00283021958306234,
    0.0015915494309189536, 0.0008949940160889102, 0.0005032921210448703, 0.00028302195830623395, 0.00015915494309189535, 8.949940160889102e-05, 5.0329212104487035e-05, 2.8302195830623396e-05};
__device__ __forceinline__ void rope_cs(int pos, int i, float& c, float& s) {
    double rv = (double)pos * ROPE_INV_REV[i]; rv -= __builtin_floor(rv); const float r = (float)rv;
    s = __builtin_amdgcn_sinf(r); c = __builtin_amdgcn_cosf(r);
}

struct RowCtx { int lane, wave, gw, ngw; };

__device__ __forceinline__ void rp_h0(const RowCtx& R, const float* x, const float* modv, bf16_t* H0, const int* positions = nullptr, float* CS = nullptr) {
    for (int task = R.gw; task < M / 16; task += R.ngw) {
        const int m0 = task * 16, b = m0 / SEQ; const float* mv = modv + (size_t)b * 6 * DM;
        f32x4 sh[4], sc[4];
#pragma unroll
        for (int j = 0; j < 4; ++j) { const int e = 8 * R.lane + 512 * (j >> 1) + 4 * (j & 1); sh[j] = *(const f32x4*)(mv + e); sc[j] = 1.f + *(const f32x4*)(mv + DM + e); }
#pragma unroll 1
        for (int rb = 0; rb < 16; rb += 4) {
            f32x4 v[4][4];
#pragma unroll
            for (int r = 0; r < 4; ++r)
#pragma unroll
                for (int j = 0; j < 4; ++j) v[r][j] = *(const f32x4*)(x + (size_t)(m0 + rb + r) * DM + 8 * R.lane + 512 * (j >> 1) + 4 * (j & 1));
#pragma unroll
            for (int r = 0; r < 4; ++r)
#pragma unroll
                for (int jp = 0; jp < 2; ++jp) { const f32x4 a0 = v[r][2 * jp] * sc[2 * jp] + sh[2 * jp], a1 = v[r][2 * jp + 1] * sc[2 * jp + 1] + sh[2 * jp + 1];
                    pg8_u32x4 w; w.x = cvt_pk_bf16(a0.x, a0.y); w.y = cvt_pk_bf16(a0.z, a0.w); w.z = cvt_pk_bf16(a1.x, a1.y); w.w = cvt_pk_bf16(a1.z, a1.w);
                    *(pg8_u32x4*)(H0 + (size_t)(m0 + rb + r) * DM + 8 * R.lane + 512 * jp) = w; }
            if (CS && R.lane < 16) {
#pragma unroll
                for (int r = 0; r < 4; ++r) { const int m = m0 + rb + r; float c, s; rope_cs(positions[m], R.lane, c, s); CS[(size_t)m * 32 + R.lane] = c; CS[(size_t)m * 32 + 16 + R.lane] = s; } }
        }
    }
}

__device__ __forceinline__ void rp_rms(const RowCtx& R, const bf16_t* Z, const int* positions, float* rstd, bf16_t* KR, float* CS) {
    for (int m = R.gw; m < M; m += R.ngw) {
        const bf16_t* z = Z + (size_t)m * ZP;
        float sq = 0.f, sk = 0.f;
        { const unsigned* p = (const unsigned*)(z + 6 * R.lane);
#pragma unroll
          for (int i = 0; i < 3; ++i) { const unsigned u = p[i]; const float a = __uint_as_float(u << 16), b = __uint_as_float(u & 0xffff0000u); sq += a * a + b * b; } }
        { const f32x4 v = ld_bf4(z + QLR + 4 * R.lane); sk = v.x * v.x + v.y * v.y + v.z * v.z + v.w * v.w; }
        sq = wave_sum(sq); sk = wave_sum(sk);
        if (R.lane == 0) { rstd[2 * m] = 1.f / sqrtf(sq * (1.f / QLR) + RMS_EPS); rstd[2 * m + 1] = 1.f / sqrtf(sk * (1.f / KVLR) + RMS_EPS); }
        if (R.lane < 16) { const float x1 = bf2f(z[QLR + KVLR + R.lane]), x2 = bf2f(z[QLR + KVLR + 16 + R.lane]); float c, s; rope_cs(positions[m], R.lane, c, s); CS[(size_t)m * 32 + R.lane] = c; CS[(size_t)m * 32 + 16 + R.lane] = s;
            KR[(size_t)m * 32 + R.lane] = f2bf(x1 * c - x2 * s); KR[(size_t)m * 32 + 16 + R.lane] = f2bf(x1 * s + x2 * c); }
    }
}

constexpr int LN1_LDS_WR = 0, LN1_LDS_SCR = NRT * DM * 4, LN1_LDS_HIST = LN1_LDS_SCR + 8 * 512, LN1_LDS_BYTES = LN1_LDS_HIST + 256;
template <bool RES_F32, bool TICKETS>
__device__ __forceinline__ void rp_ln1(LAS unsigned char* lds, int layer, const void* res, const bf16_t* ybr, const float* modv_l, const float* lng, const float* lnb,
                                       const float* w_gr, const float* b_gr, const float* w_er, const float* b_er, bf16_t* X1, bf16_t* H2,
                                       int* tok_e, float* tok_w, int* tok_t, unsigned* cnt, int* list) {
    const int tid = threadIdx.x, lane = tid & 63, wave = tid >> 6, nthr = blockDim.x, nwave = nthr >> 6;
    LAS float* wr = (LAS float*)(lds + LN1_LDS_WR);
    LAS float* scr = (LAS float*)(lds + LN1_LDS_SCR) + wave * 128;
    LAS unsigned* hist = (LAS unsigned*)(lds + LN1_LDS_HIST);
    for (int i = tid; i < DM * 4; i += nthr) { const int k = i >> 2, c = i & 3; wr[c * DM + k] = w_gr[(size_t)layer * DM * 4 + i]; }
    for (int i = tid; i < DM * 32; i += nthr) { const int k = i >> 5, c = i & 31; wr[(4 + c) * DM + k] = w_er[(size_t)layer * DM * 32 + i]; }
    if (tid < 64) hist[tid] = 0u;
    __syncthreads();
    const int rows_per_blk = M / gridDim.x, row0 = blockIdx.x * rows_per_blk;
    f32x4 lg4[4], lb4[4];
#pragma unroll
    for (int j = 0; j < 4; ++j) { lg4[j] = *(const f32x4*)(lng + 4 * lane + 256 * j); lb4[j] = *(const f32x4*)(lnb + 4 * lane + 256 * j); }
    for (int it = wave * 2; it < rows_per_blk; it += nwave * 2) {
        const int m0 = row0 + it; const int b = m0 / SEQ; const float* mv = modv_l + (size_t)b * 6 * DM;
        f32x4 h[2][4];
#pragma unroll
        for (int r = 0; r < 2; ++r) {
            const int m = m0 + r; f32x4 u[4]; float s = 0.f;
#pragma unroll
            for (int j = 0; j < 4; ++j) { const int e = 4 * lane + 256 * j;
                f32x4 rv; if (RES_F32) rv = *(const f32x4*)((const float*)res + (size_t)m * DM + e); else rv = ld_bf4((const bf16_t*)res + (size_t)m * DM + e);
                const f32x4 yv = ld_bf4(ybr + (size_t)m * DM + e), g1 = *(const f32x4*)(mv + 2 * DM + e);
                u[j] = DN_ALPHA * rv + (1.f + g1) * yv; s += hsum4(u[j]); }
            const float mean = wave_sum(s) * (1.f / DM); float s2 = 0.f;
#pragma unroll
            for (int j = 0; j < 4; ++j) { u[j] = u[j] - mean; s2 += hsum4(u[j] * u[j]); }
            const float rs = 1.f / sqrtf(wave_sum(s2) * (1.f / DM) + LN_EPS);
#pragma unroll
            for (int j = 0; j < 4; ++j) { const int e = 4 * lane + 256 * j;
                const f32x4 x1 = u[j] * rs * lg4[j] + lb4[j]; st_bf4(X1 + (size_t)m * DM + e, x1);
                const f32x4 sh = *(const f32x4*)(mv + 3 * DM + e), sc = *(const f32x4*)(mv + 4 * DM + e);
                h[r][j] = x1 * (1.f + sc) + sh; st_bf4(H2 + (size_t)m * DM + e, h[r][j]); }
        }
        float part[80];
#pragma unroll
        for (int c = 0; c < NRT; ++c) {
            const LAS f32x4* wp = (const LAS f32x4*)(wr + c * DM) + lane;
            const f32x4 w0 = wp[0], w1 = wp[64], w2 = wp[128], w3 = wp[192];
#pragma unroll
            for (int r = 0; r < 2; ++r) { const f32x4 sv = h[r][0] * w0 + h[r][1] * w1 + h[r][2] * w2 + h[r][3] * w3; part[r * 40 + c] = hsum4(sv); }
        }
#pragma unroll
        for (int c = NRT; c < 40; ++c) { part[c] = 0.f; part[40 + c] = 0.f; }
        { const bool up = (lane & 32) != 0;
#pragma unroll
          for (int i = 0; i < 40; ++i) { const float send = up ? part[i] : part[i + 40]; const float recv = __shfl_xor(send, 32); const float keep = up ? part[i + 40] : part[i]; part[i] = keep + recv; } }
        { const bool up = (lane & 16) != 0;
#pragma unroll
          for (int i = 0; i < 20; ++i) { const float send = up ? part[i] : part[i + 20]; const float recv = __shfl_xor(send, 16); const float keep = up ? part[i + 20] : part[i]; part[i] = keep + recv; } }
        { const bool up = (lane & 8) != 0;
#pragma unroll
          for (int i = 0; i < 10; ++i) { const float send = up ? part[i] : part[i + 10]; const float recv = __shfl_xor(send, 8); const float keep = up ? part[i + 10] : part[i]; part[i] = keep + recv; } }
        { const bool up = (lane & 4) != 0;
#pragma unroll
          for (int i = 0; i < 5; ++i) { const float send = up ? part[i] : part[i + 5]; const float recv = __shfl_xor(send, 4); const float keep = up ? part[i + 5] : part[i]; part[i] = keep + recv; } }
#pragma unroll
        for (int i = 0; i < 5; ++i) { part[i] += __shfl_xor(part[i], 2); part[i] += __shfl_xor(part[i], 1); }
        if ((lane & 3) == 0) { const int vb = 40 * ((lane >> 5) & 1) + 20 * ((lane >> 4) & 1) + 10 * ((lane >> 3) & 1) + 5 * ((lane >> 2) & 1);
#pragma unroll
            for (int i = 0; i < 5; ++i) scr[vb + i] = part[i]; }
        asm volatile("s_waitcnt lgkmcnt(0)" ::: "memory");
        if (lane < 2) {
            const int m = m0 + lane; const LAS float* lgt = scr + lane * 40;
            float gmax = lgt[0] + b_gr[layer * 4 + 0]; int gi = 0; float gl[4];
            gl[0] = gmax;
#pragma unroll
            for (int i = 1; i < 4; ++i) { gl[i] = lgt[i] + b_gr[layer * 4 + i]; if (gl[i] > gmax) { gmax = gl[i]; gi = i; } }
            float gs = 0.f;
#pragma unroll
            for (int i = 0; i < 4; ++i) gs += __expf(gl[i] - gmax);
            const float gp = 1.f / gs;
            float v1 = -INFINITY, v2 = -INFINITY; int i1 = 0, i2 = 0;
            for (int i = 0; i < 8; ++i) { const float v = lgt[4 + gi * 8 + i] + b_er[layer * 32 + gi * 8 + i];
                if (v > v1) { v2 = v1; i2 = i1; v1 = v; i1 = i; } else if (v > v2) { v2 = v; i2 = i; } }
            const float e2 = __expf(v2 - v1), w1 = gp / (1.f + e2), w2 = gp * e2 / (1.f + e2);
            const int e1i = gi * 8 + i1, e2i = gi * 8 + i2;
            tok_e[2 * m] = e1i; tok_e[2 * m + 1] = e2i; tok_w[2 * m] = w1; tok_w[2 * m + 1] = w2;
            if (TICKETS) { tok_t[2 * m] = (int)__hip_atomic_fetch_add(hist + e1i, 1u, __ATOMIC_RELAXED, __HIP_MEMORY_SCOPE_WORKGROUP); tok_t[2 * m + 1] = (int)__hip_atomic_fetch_add(hist + e2i, 1u, __ATOMIC_RELAXED, __HIP_MEMORY_SCOPE_WORKGROUP); }
        }
    }
    if (TICKETS) {
        __syncthreads();
        if (tid < 32) { const unsigned n = hist[tid]; hist[32 + tid] = n ? __hip_atomic_fetch_add(cnt + tid, n, __ATOMIC_RELAXED, __HIP_MEMORY_SCOPE_AGENT) : 0u; }
        __syncthreads();
        for (int i = tid; i < rows_per_blk * 2; i += nthr) { const int idx = row0 * 2 + i; const int e = tok_e[idx]; const int t = tok_t[idx] + (int)hist[32 + e]; tok_t[idx] = t; list[(size_t)e * M + t] = idx >> 1; }
    }
}

template <bool OUT_F32, bool SORTED, bool Y2F8 = false>
__device__ __forceinline__ void rp_ln2(const RowCtx& R, const bf16_t* X1, const bf16_t* Y2, const int* tok_e, const float* tok_w, const int* tok_t, const unsigned* cnt,
                                       const float* modv_l, const float* lng, const float* lnb, void* out) {
#define LN2_E(j) (8 * R.lane + 512 * ((j) >> 1) + 4 * ((j) & 1))
#define LN2_BF2(lo_, hi_) ((f32x4){__uint_as_float((lo_) << 16), __uint_as_float((lo_) & 0xffff0000u), __uint_as_float((hi_) << 16), __uint_as_float((hi_) & 0xffff0000u)})
    f32x4 lg4[4], lb4[4];
#pragma unroll
    for (int j = 0; j < 4; ++j) { lg4[j] = *(const f32x4*)(lng + LN2_E(j)); lb4[j] = *(const f32x4*)(lnb + LN2_E(j)); }
    int mybase = 0;
    if (SORTED) { const int c = (R.lane < 32) ? (int)cnt[R.lane] : 0; int pad = (c + 255) & ~255; int incl = pad;
#pragma unroll
        for (int o = 1; o < 32; o <<= 1) { const int t = __shfl_up(incl, o); if ((R.lane & 31) >= o) incl += t; }
        mybase = incl - pad; }
    for (int task = R.gw; task < M / 16; task += R.ngw) {
        const int m0 = task * 16, b = m0 / SEQ; const float* mv = modv_l + (size_t)b * 6 * DM;
        const int ml = m0 + (R.lane & 15);
        const int e0 = tok_e[2 * ml], e1 = tok_e[2 * ml + 1]; const float wl0 = tok_w[2 * ml], wl1 = tok_w[2 * ml + 1];
        int rl0, rl1;
        if (SORTED) { const int t0 = tok_t[2 * ml], t1 = tok_t[2 * ml + 1]; rl0 = __shfl(mybase, e0) + t0; rl1 = __shfl(mybase, e1) + t1; } else { rl0 = 2 * ml; rl1 = rl0 + 1; }
        f32x4 g2[4];
#pragma unroll
        for (int j = 0; j < 4; ++j) g2[j] = 1.f + *(const f32x4*)(mv + 5 * DM + LN2_E(j));
#pragma unroll 1
        for (int rb = 0; rb < 16; rb += 2) {
            f32x4 xv[2][4], ya[2][4], yb[2][4]; float w0[2], w1[2];
#pragma unroll
            for (int r = 0; r < 2; ++r) { const size_t r0 = (size_t)__shfl(rl0, rb + r), r1 = (size_t)__shfl(rl1, rb + r); w0[r] = __shfl(wl0, rb + r); w1[r] = __shfl(wl1, rb + r);
#pragma unroll
                for (int jp = 0; jp < 2; ++jp) { const int e = 8 * R.lane + 512 * jp;
                    const pg8_u32x4 xw = *(const pg8_u32x4*)(X1 + (size_t)(m0 + rb + r) * DM + e); xv[r][2 * jp] = LN2_BF2(xw.x, xw.y); xv[r][2 * jp + 1] = LN2_BF2(xw.z, xw.w);
                    if (Y2F8) { const pg8_u32x2 aw = *(const pg8_u32x2*)((const unsigned char*)Y2 + r0 * DM + e), bw = *(const pg8_u32x2*)((const unsigned char*)Y2 + r1 * DM + e);
                        ya[r][2 * jp] = unpack_f8x4(aw.x) * F8IS; ya[r][2 * jp + 1] = unpack_f8x4(aw.y) * F8IS; yb[r][2 * jp] = unpack_f8x4(bw.x) * F8IS; yb[r][2 * jp + 1] = unpack_f8x4(bw.y) * F8IS; }
                    else { const pg8_u32x4 aw = *(const pg8_u32x4*)(Y2 + r0 * DM + e), bw = *(const pg8_u32x4*)(Y2 + r1 * DM + e);
                        ya[r][2 * jp] = LN2_BF2(aw.x, aw.y); ya[r][2 * jp + 1] = LN2_BF2(aw.z, aw.w); yb[r][2 * jp] = LN2_BF2(bw.x, bw.y); yb[r][2 * jp + 1] = LN2_BF2(bw.z, bw.w); } } }
#pragma unroll
            for (int r = 0; r < 2; ++r) { const int m = m0 + rb + r; f32x4 u[4]; float s = 0.f;
#pragma unroll
                for (int j = 0; j < 4; ++j) { u[j] = DN_ALPHA * xv[r][j] + g2[j] * (w0[r] * ya[r][j] + w1[r] * yb[r][j]); s += hsum4(u[j]); }
                const float mean = wave_sum(s) * (1.f / DM); float s2 = 0.f;
#pragma unroll
                for (int j = 0; j < 4; ++j) { u[j] = u[j] - mean; s2 += hsum4(u[j] * u[j]); }
                const float rs = 1.f / sqrtf(wave_sum(s2) * (1.f / DM) + LN_EPS);
#pragma unroll
                for (int jp = 0; jp < 2; ++jp) { const int e = 8 * R.lane + 512 * jp; const f32x4 o0 = u[2 * jp] * rs * lg4[2 * jp] + lb4[2 * jp], o1 = u[2 * jp + 1] * rs * lg4[2 * jp + 1] + lb4[2 * jp + 1];
                    if (OUT_F32) { *(f32x4*)((float*)out + (size_t)m * DM + e) = o0; *(f32x4*)((float*)out + (size_t)m * DM + e + 4) = o1; }
                    else { pg8_u32x4 w; w.x = cvt_pk_bf16(o0.x, o0.y); w.y = cvt_pk_bf16(o0.z, o0.w); w.z = cvt_pk_bf16(o1.x, o1.y); w.w = cvt_pk_bf16(o1.z, o1.w); *(pg8_u32x4*)((bf16_t*)out + (size_t)m * DM + e) = w; } } }
        }
    }
#undef LN2_E
#undef LN2_BF2
}

__device__ __forceinline__ void rp_pool(const RowCtx& R, const bf16_t* X2, const float* modv_l, bf16_t* MIX) {
    for (int task = R.gw; task < M / 16; task += R.ngw) {
        const int m0 = task * 16, b = m0 / SEQ, t0 = m0 % SEQ; const float* mv = modv_l + (size_t)b * 6 * DM;
        f32x4 sh[4], sc[4], S[4];
#pragma unroll
        for (int j = 0; j < 4; ++j) { const int e = 4 * R.lane + 256 * j; sh[j] = *(const f32x4*)(mv + e); sc[j] = 1.f + *(const f32x4*)(mv + DM + e); S[j] = (f32x4){0.f, 0.f, 0.f, 0.f}; }
#pragma unroll
        for (int j = 0; j < 4; ++j) { const int w = 2 << j, e = 4 * R.lane + 256 * j;
            for (int i = 1; i < w; ++i) if (t0 - i >= 0) S[j] += ld_bf4(X2 + (size_t)(m0 - i) * DM + e) * sc[j] + sh[j]; }
#pragma unroll 1
        for (int rb = 0; rb < 16; rb += 4) {
            pg8_u32x2 cur[4][4], lag[4][4];
#pragma unroll
            for (int r = 0; r < 4; ++r)
#pragma unroll
                for (int j = 0; j < 4; ++j) { const int w = 2 << j, e = 4 * R.lane + 256 * j; const int m = m0 + rb + r, t = t0 + rb + r;
                    cur[r][j] = *(const pg8_u32x2*)(X2 + (size_t)m * DM + e);
                    lag[r][j] = (t - w + 1 >= 0) ? *(const pg8_u32x2*)(X2 + (size_t)(m - w + 1) * DM + e) : (pg8_u32x2){0u, 0u}; }
#pragma unroll
            for (int r = 0; r < 4; ++r) { const int m = m0 + rb + r, t = t0 + rb + r;
#pragma unroll
                for (int j = 0; j < 4; ++j) { const int w = 2 << j, e = 4 * R.lane + 256 * j;
                    const f32x4 hv = (f32x4){__uint_as_float(cur[r][j].x << 16), __uint_as_float(cur[r][j].x & 0xffff0000u), __uint_as_float(cur[r][j].y << 16), __uint_as_float(cur[r][j].y & 0xffff0000u)} * sc[j] + sh[j]; S[j] += hv;
                    const float inv = 1.f / (float)((t + 1 < w) ? (t + 1) : w);
                    st_bf4(MIX + (size_t)m * DM + e, S[j] * inv - hv);
                    if (t - w + 1 >= 0) S[j] -= (f32x4){__uint_as_float(lag[r][j].x << 16), __uint_as_float(lag[r][j].x & 0xffff0000u), __uint_as_float(lag[r][j].y << 16), __uint_as_float(lag[r][j].y & 0xffff0000u)} * sc[j] + sh[j]; }
            }
        }
    }
}

__global__ void __launch_bounds__(256) nk_mod(const float* c, const float* w_mod, const float* b_mod, float* modv) {
    const int idx = blockIdx.x * 256 + threadIdx.x; const int j = idx % 6144, b = (idx / 6144) % 8, l = idx / (6144 * 8);
    float acc = b_mod[l * 6144 + j]; const float* w = w_mod + (size_t)l * DM * 6144 + j; const float* cb = c + b * DM;
    for (int k = 0; k < DM; ++k) { const float cv = cb[k]; acc += (cv / (1.f + __expf(-cv))) * w[(size_t)k * 6144]; }
    modv[idx] = acc;
}
__global__ void __launch_bounds__(512) rk_h0(const float* x, const float* modv, bf16_t* H0) { RowCtx R{(int)threadIdx.x & 63, (int)threadIdx.x >> 6, (int)(blockIdx.x * 8 + (threadIdx.x >> 6)), (int)gridDim.x * 8}; rp_h0(R, x, modv, H0); }
__global__ void __launch_bounds__(512) rk_rms(const bf16_t* Z, const int* pos, float* rstd, bf16_t* KR, float* CS) { RowCtx R{(int)threadIdx.x & 63, (int)threadIdx.x >> 6, (int)(blockIdx.x * 8 + (threadIdx.x >> 6)), (int)gridDim.x * 8}; rp_rms(R, Z, pos, rstd, KR, CS); }
template <bool RES_F32, bool TICKETS>
__global__ void __launch_bounds__(512) rk_ln1(int layer, const void* res, const bf16_t* ybr, const float* modv_l, const float* lng, const float* lnb, const float* w_gr, const float* b_gr, const float* w_er, const float* b_er,
                                             bf16_t* X1, bf16_t* H2, int* tok_e, float* tok_w, int* tok_t, unsigned* cnt, int* list) {
    extern __shared__ __attribute__((aligned(16))) unsigned char lds_dyn[];
    rp_ln1<RES_F32, TICKETS>((LAS unsigned char*)lds_dyn, layer, res, ybr, modv_l, lng, lnb, w_gr, b_gr, w_er, b_er, X1, H2, tok_e, tok_w, tok_t, cnt, list);
}
template <bool OUT_F32, bool SORTED>
__global__ void __launch_bounds__(512) rk_ln2(const bf16_t* X1, const bf16_t* Y2, const int* tok_e, const float* tok_w, const int* tok_t, const unsigned* cnt, const float* modv_l, const float* lng, const float* lnb, void* out) {
    RowCtx R{(int)threadIdx.x & 63, (int)threadIdx.x >> 6, (int)(blockIdx.x * 8 + (threadIdx.x >> 6)), (int)gridDim.x * 8}; rp_ln2<OUT_F32, SORTED>(R, X1, Y2, tok_e, tok_w, tok_t, cnt, modv_l, lng, lnb, out);
}
__global__ void __launch_bounds__(512) rk_pool(const bf16_t* X2, const float* modv_l, bf16_t* MIX) { RowCtx R{(int)threadIdx.x & 63, (int)threadIdx.x >> 6, (int)(blockIdx.x * 8 + (threadIdx.x >> 6)), (int)gridDim.x * 8}; rp_pool(R, X2, modv_l, MIX); }

struct EpiPlain { bf16_t* O; const float* rowscale; const float* colscale; int ldo; int rs_stride; float scale; int pad;
    __device__ __forceinline__ void operator()(int m, int n, float v) const { float s = scale; if (rowscale) s *= rowscale[(size_t)m * rs_stride]; if (colscale) s *= colscale[n]; O[(size_t)m * ldo + n] = f2bf(v * s); } };
static EpiPlain mk_epi(bf16_t* O, int ldo, const float* rowscale, int rs_stride, float scale, const float* colscale) { EpiPlain e{}; e.O = O; e.rowscale = rowscale; e.colscale = colscale; e.ldo = ldo; e.rs_stride = rs_stride; e.scale = scale; e.pad = 0; return e; }
template <class Epi>
__global__ void __launch_bounds__(256) nk_gemm(const bf16_t* A, int lda, const float* W, int ldw, const float* kscale, int K, int N, Epi epi) {
    const int n = blockIdx.x * 256 + threadIdx.x, m0 = blockIdx.y * 8;
    if (n >= N) return;
    float acc[8];
#pragma unroll
    for (int r = 0; r < 8; ++r) acc[r] = 0.f;
    for (int k = 0; k < K; ++k) { float w = W[(size_t)k * ldw + n]; if (kscale) w *= kscale[k];
#pragma unroll
        for (int r = 0; r < 8; ++r) acc[r] += bf2f(A[(size_t)(m0 + r) * lda + k]) * w; }
#pragma unroll
    for (int r = 0; r < 8; ++r) epi(m0 + r, n, acc[r]);
}
__global__ void __launch_bounds__(256) nk_rope_q(bf16_t* Q, const int* positions) {
    const int idx = blockIdx.x * 256 + threadIdx.x; const int i = idx & 15, h = (idx >> 4) & 15, m = idx >> 8;
    if (m >= M) return;
    bf16_t* p = Q + (size_t)m * QP + h * DQK + DNOPE; const float x1 = bf2f(p[i]), x2 = bf2f(p[16 + i]); float c, s; rope_cs(positions[m], i, c, s);
    p[i] = f2bf(x1 * c - x2 * s); p[16 + i] = f2bf(x1 * s + x2 * c);
}
__global__ void __launch_bounds__(64) nk_attn(const bf16_t* Q, const bf16_t* KVB, const bf16_t* KR, bf16_t* O) {
    const int lane = threadIdx.x, qc = blockIdx.x, h = blockIdx.y, b = blockIdx.z;
    const int t = qc * 64 + lane; const size_t rowb = (size_t)b * SEQ;
    float q[DQK], o[DV];
    { const bf16_t* qp = Q + (rowb + t) * QP + h * DQK;
#pragma unroll
      for (int d = 0; d < DQK; d += 4) { const f32x4 v = ld_bf4(qp + d); q[d] = v.x; q[d + 1] = v.y; q[d + 2] = v.z; q[d + 3] = v.w; } }
#pragma unroll
    for (int d = 0; d < DV; ++d) o[d] = 0.f;
    float mx = -INFINITY, l = 0.f;
    const int kend = qc * 64 + 63;
    for (int k = 0; k <= kend; ++k) {
        const bf16_t* kp = KVB + (rowb + k) * KVP + h * 128; const bf16_t* rp = KR + (rowb + k) * 32;
        float s = 0.f;
#pragma unroll
        for (int d = 0; d < DNOPE; d += 4) { const f32x4 v = ld_bf4(kp + d); s += q[d] * v.x + q[d + 1] * v.y + q[d + 2] * v.z + q[d + 3] * v.w; }
#pragma unroll
        for (int d = 0; d < DROPE; d += 4) { const f32x4 v = ld_bf4(rp + d); s += q[64 + d] * v.x + q[65 + d] * v.y + q[66 + d] * v.z + q[67 + d] * v.w; }
        if (k > t) s = -INFINITY;
        const float mn = fmaxf(mx, s); const float f = exp2f(mx - mn), p = exp2f(s - mn);
        l = l * f + p; mx = mn;
#pragma unroll
        for (int d = 0; d < DV; d += 4) { const f32x4 v = ld_bf4(kp + 64 + d); o[d] = o[d] * f + p * v.x; o[d + 1] = o[d + 1] * f + p * v.y; o[d + 2] = o[d + 2] * f + p * v.z; o[d + 3] = o[d + 3] * f + p * v.w; }
    }
    const float il = 1.f / l; bf16_t* op = O + (rowb + t) * DM + h * DV;
#pragma unroll
    for (int d = 0; d < DV; d += 4) st_bf4(op + d, (f32x4){o[d] * il, o[d + 1] * il, o[d + 2] * il, o[d + 3] * il});
}
__global__ void __launch_bounds__(256) nk_moe(const bf16_t* H2, const int* tok_e, const float* wg, const float* wu, const float* wd, bf16_t* Y2) {
    __shared__ float hs[DM]; __shared__ float he[FF];
    const int p = blockIdx.x, m = p >> 1, tid = threadIdx.x; const int e = tok_e[p];
    for (int i = tid; i < DM; i += 256) hs[i] = bf2f(H2[(size_t)m * DM + i]);
    __syncthreads();
    const float* Wg = wg + (size_t)e * DM * FF + tid; const float* Wu = wu + (size_t)e * DM * FF + tid;
    float g = 0.f, u = 0.f;
    for (int k = 0; k < DM; ++k) { g += hs[k] * Wg[(size_t)k * FF]; u += hs[k] * Wu[(size_t)k * FF]; }
    he[tid] = g / (1.f + __expf(-g)) * u;
    __syncthreads();
    const float* Wd = wd + (size_t)e * FF * DM;
#pragma unroll
    for (int c = 0; c < 4; ++c) { const int col = tid + 256 * c; float a = 0.f; for (int j = 0; j < FF; ++j) a += he[j] * Wd[(size_t)j * DM + col]; Y2[(size_t)p * DM + col] = f2bf(a); }
}

namespace pg8 {
typedef short bf16x8 __attribute__((ext_vector_type(8)));
typedef unsigned u32x4 __attribute__((ext_vector_type(4)));
typedef unsigned u32x2 __attribute__((ext_vector_type(2)));
constexpr int BM = 256, BK = 64, HALF = 128, HTB = HALF * BK * 2, STAGE_BYTES = 8 * HTB, NXCD = 8, WGM = 8;
__host__ __device__ __forceinline__ int lds_byte(int r, int c) { const int st = (r >> 4) * 2 + (c >> 5), rr = r & 15, cc = c & 31, ob = rr * 64 + cc * 2; return st * 1024 + (ob ^ (((ob >> 9) & 1) << 5)); }
__host__ __device__ __forceinline__ void stage_rc(int b, int& R, int& C) { const int st = b / 1024, sb = b % 1024, swz = sb ^ (((sb >> 9) & 1) << 5); R = (st >> 1) * 16 + swz / 64; C = (st & 1) * 32 + (swz % 64) / 2; }
__host__ __device__ __forceinline__ int perm32(int rho) { const int n = rho >> 4, i = rho & 15; return 8 * (i >> 2) + 4 * n + (i & 3); }

struct Unit { int pm, pn, e, cnt, slot, pad; const char* a; const char* b; };

template <int NN, bool SPLIT = false>
struct StaticOrderT {
    static constexpr int nM = M / BM, nN = NN, nwg = nM * nN, nig = WGM * nN;
    static constexpr bool HALF_UNITS = SPLIT;
    static_assert(nM % WGM == 0 && nwg % NXCD == 0, "StaticOrderT: whole groups, whole XCD shares");
    int G, c; const char* A; const char* Bt; int lda, ldb;
    __device__ void init(const void* A_, int lda_, const void* Bt_, int ldb_, int, int, int G_, int c_) { A = (const char*)A_; Bt = (const char*)Bt_; lda = lda_; ldb = ldb_; G = G_; c = c_; }
    __device__ __forceinline__ bool next(int i, Unit& u) const {
        int L = i * G + c, hf = 0;
        if (SPLIT && 2 * nwg == 3 * G) { if (i == 1) { L = G + (c >> 1); hf = 1 + (c & 1); } else if (i > 1) return false; }
        if (L >= nwg) return false;
        const int wgid = (L % NXCD) * (nwg / NXCD) + L / NXCD;
        const int gid = wgid / nig, rem = wgid % nig;
        u.pm = gid * WGM + (rem % WGM); u.pn = rem / WGM; u.e = 0; u.cnt = 0; u.slot = i; u.pad = hf;
        u.a = A + ((size_t)u.pm * BM + (hf == 2 ? HALF : 0)) * lda * 2; u.b = Bt + (size_t)u.pn * BM * ldb * 2; return true;
    }
    __device__ __forceinline__ unsigned a_row_off(const Unit&, int r) const { return (unsigned)(r * lda * 2); }
};
struct BlockDiagOrder {
    static constexpr bool HALF_UNITS = false;
    int nM, G, c; const char* A; const char* Bt; int lda;
    __device__ void init(const void* A_, int lda_, const void* Bt_, int Mr, int G_, int c_) { A = (const char*)A_; Bt = (const char*)Bt_; lda = lda_; nM = Mr / BM; G = G_; c = c_; }
    __device__ __forceinline__ bool next(int i, Unit& u) const {
        const int L = i * G + c; if (L >= nM * 4) return false;
        u.pm = L >> 2; u.pn = L & 3; u.e = 0; u.cnt = 0; u.slot = 0; u.pad = 0;
        u.a = A + ((size_t)u.pm * BM * lda + 256 * u.pn) * 2; u.b = Bt + (size_t)u.pn * 256 * 256 * 2; return true;
    }
    __device__ __forceinline__ unsigned a_row_off(const Unit&, int r) const { return (unsigned)(r * lda * 2); }
};
template <int NCOL, bool SPLIT = false>
struct MoeOrder {
    static constexpr int ncol = NCOL; static constexpr bool HALF_UNITS = SPLIT;
    int G, c, gather; const LAS int* tb; const LAS int* rowtab; const unsigned* cnt; const char* A; const char* Bt; int lda; size_t bstride;
    __device__ __forceinline__ int tail_busy() const { const int T = tb[32] * ncol, tail = T % G; return (SPLIT && 2 * tail <= G) ? 2 * tail : tail; }
    __device__ __forceinline__ bool next(int i, Unit& u) const {
        int L = i * G + c, hf = 0; const int total = tb[32];
        if (SPLIT) { const int T = total * ncol, R = T / G, tail = T - R * G;
            if (i == R && 2 * tail <= G) { if (c >= 2 * tail) return false; L = R * G + (c >> 1); hf = 1 + (c & 1); } }
        if (L >= total * ncol) return false;
        const int rt = L / ncol; u.pn = L - rt * ncol; int e = 0;
#pragma unroll 1
        for (int j = 16; j >= 1; j >>= 1) if (tb[e + j] <= rt) e += j;
        u.pm = rt; u.e = e; u.cnt = (int)cnt[e] - (rt - tb[e]) * BM; u.slot = i; u.pad = hf;
        if (hf == 2 && u.cnt <= HALF) return false;
        u.a = gather ? A : A + ((size_t)rt * BM + (hf == 2 ? HALF : 0)) * lda * 2;
        u.b = Bt + (size_t)e * bstride + (size_t)u.pn * BM * (bstride / (ncol * BM)); return true;
    }
    __device__ __forceinline__ unsigned a_row_off(const Unit& u, int r) const { return gather ? (unsigned)rowtab[u.slot * 256 + r] * (unsigned)(lda * 2) : (unsigned)(r * lda * 2); }
};

template <bool ROPE, bool F8 = false>
struct EpiStore {
    static constexpr bool PERM = true; static constexpr int NSTORE = F8 ? 8 : 16;
    bf16_t* O; int ldo; const float* rowscale; int rs; float scale; const float* colscale; const float* CS; int nostore = 0; const float* ssq = nullptr; int ssq_off = 0, ssq_n = 0; float ssq_inv = 0.f; const LAS float* lds_rs = nullptr;
    __device__ __forceinline__ void operator()(const f32x4 (&acc)[2][2][4][2], const Unit& u, int wr, int wc, int fr, int fq) const {
        const int row0 = u.pm * BM + (u.pad == 2 ? HALF : 0) + wr * 64 + fr, col0 = u.pn * BM + wc * 32 + 8 * fq; const bool full = (u.pad == 0);
        float rsc[2][4];
#pragma unroll
        for (int ai = 0; ai < 2; ++ai)
#pragma unroll
            for (int m = 0; m < 4; ++m) {
                if (lds_rs) rsc[ai][m] = scale * lds_rs[u.slot * 256 + wr * 64 + fr + ai * HALF + m * 16];
                else if (ssq) { const float* p = ssq + (size_t)(row0 + ai * HALF + m * 16) * 24 + ssq_off; float s = hsum4(*(const f32x4*)p) + hsum4(*(const f32x4*)(p + 4)); if (ssq_n == 12) s += hsum4(*(const f32x4*)(p + 8));
                    rsc[ai][m] = scale / sqrtf(s * ssq_inv + RMS_EPS); }
                else rsc[ai][m] = rowscale ? scale * rowscale[(size_t)(row0 + ai * HALF + m * 16) * rs] : scale; }
        f32x4 cs[2][2];
#pragma unroll
        for (int bj = 0; bj < 2; ++bj) { cs[bj][0] = (f32x4){1.f, 1.f, 1.f, 1.f}; cs[bj][1] = cs[bj][0];
            if (colscale) { cs[bj][0] = *(const f32x4*)(colscale + col0 + bj * HALF); cs[bj][1] = *(const f32x4*)(colscale + col0 + bj * HALF + 4); } }
        const int g0 = col0 >> 5; const bool rope0 = ROPE && ((g0 % 3) == 2), rope1 = ROPE && (((g0 + 4) % 3) == 2);
#define EPI_STORE_PLAIN(bj, ai) do { if (F8) { _Pragma("unroll") for (int m = 0; m < 4; m += 2) { const float sA = rsc[ai][m], sB = rsc[ai][m + 1]; \
            const f32x4 a0 = acc[ai][bj][m][0] * sA * cs[bj][0], a1 = acc[ai][bj][m][1] * sA * cs[bj][1], b0 = acc[ai][bj][m + 1][0] * sB * cs[bj][0], b1 = acc[ai][bj][m + 1][1] * sB * cs[bj][1]; \
            unsigned xA = pack_f8x4(a0[0], a0[1], a0[2], a0[3]), yA = pack_f8x4(a1[0], a1[1], a1[2], a1[3]), xB = pack_f8x4(b0[0], b0[1], b0[2], b0[3]), yB = pack_f8x4(b1[0], b1[1], b1[2], b1[3]); \
            { auto r_ = __builtin_amdgcn_permlane16_swap(xA, xB, false, false); xA = r_[0]; xB = r_[1]; } { auto r_ = __builtin_amdgcn_permlane16_swap(yA, yB, false, false); yA = r_[0]; yB = r_[1]; } \
            const int row = row0 + (ai) * HALF + (m + (fq & 1)) * 16; \
            if (!nostore) *(u32x4*)((unsigned char*)O + (size_t)row * ldo + col0 + (bj) * HALF - ((fq & 1) ? 8 : 0)) = (u32x4){xA, yA, xB, yB}; } } \
        else { _Pragma("unroll") for (int m = 0; m < 4; ++m) { const int row = row0 + (ai) * HALF + m * 16; const float s = rsc[ai][m]; \
            const f32x4 v0 = acc[ai][bj][m][0] * s * cs[bj][0], v1 = acc[ai][bj][m][1] * s * cs[bj][1]; \
            u32x4 w; w.x = cvt_pk_bf16(v0[0], v0[1]); w.y = cvt_pk_bf16(v0[2], v0[3]); w.z = cvt_pk_bf16(v1[0], v1[1]); w.w = cvt_pk_bf16(v1[2], v1[3]); \
            if (!nostore) *(u32x4*)(O + (size_t)row * ldo + col0 + (bj) * HALF) = w; } } } while (0)
#define EPI_LOAD_CS(ai) do { _Pragma("unroll") for (int m = 0; m < 4; ++m) { const float* cp = CS + (size_t)(row0 + (ai) * HALF + m * 16) * 32 + 4 * fq; c4[m] = *(const f32x4*)cp; s4[m] = *(const f32x4*)(cp + 16); } } while (0)
#define EPI_STORE_ROPE(bj, ai) do { _Pragma("unroll") for (int m = 0; m < 4; ++m) { const int row = row0 + (ai) * HALF + m * 16; const float s = rsc[ai][m]; \
            const f32x4 v0 = acc[ai][bj][m][0] * s, v1 = acc[ai][bj][m][1] * s; \
            const f32x4 y0 = v0 * c4[m] - v1 * s4[m], y1 = v0 * s4[m] + v1 * c4[m]; \
            bf16_t* gp = O + (size_t)row * ldo + (col0 + (bj) * HALF - 8 * fq); \
            u32x2 w0, w1; w0.x = cvt_pk_bf16(y0[0], y0[1]); w0.y = cvt_pk_bf16(y0[2], y0[3]); w1.x = cvt_pk_bf16(y1[0], y1[1]); w1.y = cvt_pk_bf16(y1[2], y1[3]); \
            *(u32x2*)(gp + 4 * fq) = w0; *(u32x2*)(gp + 16 + 4 * fq) = w1; } } while (0)
        if (rope0) {
            f32x4 c4[4], s4[4];
            EPI_LOAD_CS(0); EPI_STORE_ROPE(0, 0);
            EPI_LOAD_CS(1);
            EPI_STORE_PLAIN(1, 0); EPI_STORE_PLAIN(1, 1);
            EPI_STORE_ROPE(0, 1);
        } else if (rope1) {
            f32x4 c4[4], s4[4];
            EPI_LOAD_CS(0); EPI_STORE_ROPE(1, 0);
            EPI_LOAD_CS(1);
            EPI_STORE_PLAIN(0, 0); EPI_STORE_PLAIN(0, 1);
            EPI_STORE_ROPE(1, 1);
        } else {
            EPI_STORE_PLAIN(0, 0); if (full) EPI_STORE_PLAIN(0, 1); EPI_STORE_PLAIN(1, 0); if (full) EPI_STORE_PLAIN(1, 1);
        }
#undef EPI_STORE_PLAIN
#undef EPI_LOAD_CS
#undef EPI_STORE_ROPE
    }
};
struct EpiZ {
    static constexpr bool PERM = true; static constexpr int NSTORE = 16;
    bf16_t* Z; float* SSQ; bf16_t* KR; const float* CS;
    __device__ __forceinline__ void operator()(const f32x4 (&acc)[2][2][4][2], const Unit& u, int wr, int wc, int fr, int fq) const {
        const int row0 = u.pm * BM + (u.pad == 2 ? HALF : 0) + wr * 64 + fr, col0 = u.pn * BM + wc * 32 + 8 * fq;
        const int nai = u.pad ? 1 : 2;
#pragma unroll
        for (int bj = 0; bj < 2; ++bj) {
            const int h = 2 * u.pn + bj;
            if (h < 5) {
#pragma unroll
                for (int ai = 0; ai < 2; ++ai) if (ai < nai)
#pragma unroll
                    for (int m = 0; m < 4; ++m) { const int row = row0 + ai * HALF + m * 16; const f32x4 v0 = acc[ai][bj][m][0], v1 = acc[ai][bj][m][1];
                        u32x4 w; w.x = cvt_pk_bf16(v0[0], v0[1]); w.y = cvt_pk_bf16(v0[2], v0[3]); w.z = cvt_pk_bf16(v1[0], v1[1]); w.w = cvt_pk_bf16(v1[2], v1[3]);
                        *(u32x4*)(Z + (size_t)row * ZP + col0 + bj * HALF) = w;
                        float s = hsum4(v0 * v0) + hsum4(v1 * v1); s += __shfl_xor(s, 16); s += __shfl_xor(s, 32);
                        if (fq == 0) SSQ[(size_t)row * 24 + h * 4 + wc] = s; }
            } else if (wc == 0) {
#pragma unroll
                for (int ai = 0; ai < 2; ++ai) if (ai < nai) { f32x4 c4[4], s4[4];
#pragma unroll
                    for (int m = 0; m < 4; ++m) { const float* cp = CS + (size_t)(row0 + ai * HALF + m * 16) * 32 + 4 * fq; c4[m] = *(const f32x4*)cp; s4[m] = *(const f32x4*)(cp + 16); }
#pragma unroll
                    for (int m = 0; m < 4; ++m) { const int row = row0 + ai * HALF + m * 16; const f32x4 v0 = acc[ai][bj][m][0], v1 = acc[ai][bj][m][1];
                        const f32x4 y0 = v0 * c4[m] - v1 * s4[m], y1 = v0 * s4[m] + v1 * c4[m];
                        u32x2 w0, w1; w0.x = cvt_pk_bf16(y0[0], y0[1]); w0.y = cvt_pk_bf16(y0[2], y0[3]); w1.x = cvt_pk_bf16(y1[0], y1[1]); w1.y = cvt_pk_bf16(y1[2], y1[3]);
                        *(u32x2*)(KR + (size_t)row * 32 + 4 * fq) = w0; *(u32x2*)(KR + (size_t)row * 32 + 16 + 4 * fq) = w1; } }
            }
        }
    }
};
struct EpiGU {
    static constexpr bool PERM = true; static constexpr int NSTORE = 8;
    bf16_t* HE;
    __device__ __forceinline__ void operator()(const f32x4 (&acc)[2][2][4][2], const Unit& u, int wr, int wc, int fr, int fq) const {
        const int row0 = u.pm * BM + (u.pad == 2 ? HALF : 0) + wr * 64 + fr, j0 = u.pn * 128 + wc * 16 + 4 * fq; const int nai = u.pad ? 1 : 2;
#pragma unroll
        for (int ai = 0; ai < 2; ++ai) if (ai < nai)
#pragma unroll
            for (int m = 0; m < 4; m += 2)
#pragma unroll
                for (int bj = 0; bj < 2; ++bj) { unsigned w[2][2];
#pragma unroll
                    for (int q = 0; q < 2; ++q) { const f32x4 g = acc[ai][bj][m + q][0], up = acc[ai][bj][m + q][1]; f32x4 h;
#pragma unroll
                        for (int x = 0; x < 4; ++x) h[x] = g[x] * __builtin_amdgcn_rcpf(1.f + __expf(-g[x])) * up[x];
                        w[q][0] = cvt_pk_bf16(h[0], h[1]); w[q][1] = cvt_pk_bf16(h[2], h[3]); }
                    { auto r_ = __builtin_amdgcn_permlane16_swap(w[0][0], w[1][0], false, false); w[0][0] = r_[0]; w[1][0] = r_[1]; }
                    { auto r_ = __builtin_amdgcn_permlane16_swap(w[0][1], w[1][1], false, false); w[0][1] = r_[0]; w[1][1] = r_[1]; }
                    bf16_t* p = HE + (size_t)(row0 + ai * HALF + (m + (fq & 1)) * 16) * FF + j0 + bj * 64 - ((fq & 1) ? 4 : 0);
                    *(u32x4*)p = (u32x4){w[0][0], w[0][1], w[1][0], w[1][1]}; }
    }
};

template <class Epi, class Sched, bool ALIGN_EPI>
__device__ __forceinline__ void gemm_phase(LAS unsigned char* lds, const int K, const int ldb, const Sched& S, const Epi& E) {
    const int tid = threadIdx.x, wid = __builtin_amdgcn_readfirstlane(tid >> 6), lane = tid & 63, wr = wid >> 2, wc = wid & 3, fr = lane & 15, fq = lane >> 4;
    const int nt = K / BK;
    int RA[2]; unsigned CA2[2], voffB[2];
#pragma unroll
    for (int i = 0; i < 2; ++i) { int R, C; stage_rc(tid * 16 + i * 8192, R, C); const int Rb = Epi::PERM ? ((R & ~31) + perm32(R & 31)) : R;
        RA[i] = R; CA2[i] = (unsigned)C * 2u; voffB[i] = (unsigned)(Rb * ldb + C) * 2u; }
    const size_t kstep = (size_t)(BK * 2);
    const size_t hstepB = (size_t)HALF * ldb * 2;
    const unsigned ldsw = (unsigned)wid * 1024u;
    const int aoff = lds_byte(wr * 64 + fr, fq * 8), boff = lds_byte(wc * 32 + fr, fq * 8);
#define PG8_SA(b, h) (((b) * 2 + (h)) * HTB)
#define PG8_SB(b, h) ((4 + (b) * 2 + (h)) * HTB)
#define PG8_STAGE_B(bufoff, gbase) do { _Pragma("unroll") for (int _i = 0; _i < 2; ++_i) \
        __builtin_amdgcn_global_load_lds((const unsigned*)((const char*)(gbase) + voffB[_i]), (LAS unsigned*)(lds + (bufoff) + ldsw + _i * 8192), 16, 0, 0); } while (0)
#define PG8_STAGE_A(bufoff, gbase, v) do { _Pragma("unroll") for (int _i = 0; _i < 2; ++_i) \
        __builtin_amdgcn_global_load_lds((const unsigned*)((const char*)(gbase) + (v)[_i]), (LAS unsigned*)(lds + (bufoff) + ldsw + _i * 8192), 16, 0, 0); } while (0)
#define PG8_LDA(dst, b, h) do { _Pragma("unroll") for (int m = 0; m < 4; ++m) _Pragma("unroll") for (int k = 0; k < 2; ++k) dst[m][k] = *(const LAS bf16x8*)(lds + PG8_SA(b, h) + aoff + m * 2048 + k * 1024); } while (0)
#define PG8_LDB(dst, b, h) do { _Pragma("unroll") for (int n = 0; n < 2; ++n) _Pragma("unroll") for (int k = 0; k < 2; ++k) dst[n][k] = *(const LAS bf16x8*)(lds + PG8_SB(b, h) + boff + n * 2048 + k * 1024); } while (0)
#define PG8_MMA(ai, bj, At, Bt) do { __builtin_amdgcn_s_setprio(1); _Pragma("unroll") for (int m = 0; m < 4; ++m) _Pragma("unroll") for (int n = 0; n < 2; ++n) _Pragma("unroll") for (int k = 0; k < 2; ++k) \
        acc[ai][bj][m][n] = __builtin_amdgcn_mfma_f32_16x16x32_bf16(Bt[n][k], At[m][k], acc[ai][bj][m][n], 0, 0, 0); __builtin_amdgcn_s_setprio(0); } while (0)
#define PG8_WAIT_V(n) asm volatile("s_waitcnt vmcnt(" #n ")" ::: "memory")
#define PG8_WAIT_L(n) asm volatile("s_waitcnt lgkmcnt(" #n ")" ::: "memory")
#define PG8_BAR __builtin_amdgcn_s_barrier()
#define PG8_SCHED __builtin_amdgcn_sched_barrier(0)
    Unit cur, nxt; int ui = 0;
    if (!S.next(0, cur)) return;
    f32x4 acc[2][2][4][2];
#pragma unroll
    for (int a = 0; a < 2; ++a)
#pragma unroll
        for (int b = 0; b < 2; ++b)
#pragma unroll
            for (int m = 0; m < 4; ++m)
#pragma unroll
                for (int n = 0; n < 2; ++n) acc[a][b][m][n] = (f32x4){0.f, 0.f, 0.f, 0.f};
    bf16x8 At[4][2], B0[2][2], B1[2][2];
    unsigned vA[2][2], nvA[2][2];
#pragma unroll
    for (int h = 0; h < 2; ++h)
#pragma unroll
        for (int i = 0; i < 2; ++i) vA[h][i] = S.a_row_off(cur, ((Sched::HALF_UNITS && cur.pad) ? 0 : h * HALF) + RA[i]) + CA2[i];
    const char* cA = cur.a; const char* cB = cur.b; bool prev_half = false;
    PG8_STAGE_B(PG8_SB(0, 0), cB); PG8_STAGE_B(PG8_SB(0, 1), cB + hstepB); PG8_STAGE_A(PG8_SA(0, 0), cA, vA[0]); PG8_STAGE_A(PG8_SA(0, 1), cA, vA[1]);
    if (wr == 1) PG8_BAR;
    PG8_WAIT_V(2); PG8_BAR;
    PG8_STAGE_B(PG8_SB(1, 0), cB + kstep); PG8_STAGE_A(PG8_SA(1, 0), cA + kstep, vA[0]); PG8_STAGE_B(PG8_SB(1, 1), cB + hstepB + kstep);
    PG8_WAIT_V(6); PG8_BAR;
    for (;;) {
        const bool has_next = S.next(ui + 1, nxt);
        const char* nA = has_next ? nxt.a : cA; const char* nB = has_next ? nxt.b : cB;
#pragma unroll
        for (int h = 0; h < 2; ++h)
#pragma unroll
            for (int i = 0; i < 2; ++i) nvA[h][i] = has_next ? (S.a_row_off(nxt, ((Sched::HALF_UNITS && nxt.pad) ? 0 : h * HALF) + RA[i]) + CA2[i]) : vA[h][i];
        const bool half = Sched::HALF_UNITS && cur.pad != 0;
#pragma unroll 1
        for (int t = 0; t < nt; t += 2) {
            const bool last = (t == nt - 2);
            const char* a1 = cA + (size_t)(t + 1) * kstep;
            const char* a2 = last ? nA : cA + (size_t)(t + 2) * kstep; const char* b2 = last ? nB : cB + (size_t)(t + 2) * kstep;
            const char* a3 = a2 + kstep; const char* b3 = b2 + kstep;
            unsigned wA0[2], wA1[2];
#pragma unroll
            for (int i = 0; i < 2; ++i) { wA0[i] = last ? nvA[0][i] : vA[0][i]; wA1[i] = last ? nvA[1][i] : vA[1][i]; }
            const bool after_epi = (t == 0) && (ui > 0) && !prev_half;
            PG8_LDB(B0, 0, 0); PG8_LDB(B1, 0, 1); PG8_SCHED; PG8_LDA(At, 0, 0); PG8_STAGE_A(PG8_SA(1, 1), a1, vA[1]);
            if (after_epi) { if constexpr (Epi::NSTORE >= 16) PG8_WAIT_V(24); else PG8_WAIT_V(16); } else PG8_WAIT_V(8);
            PG8_WAIT_L(0); PG8_BAR; PG8_MMA(0, 0, At, B0); PG8_MMA(0, 1, At, B1); PG8_BAR; PG8_SCHED;
            PG8_LDA(At, 0, 1); PG8_STAGE_B(PG8_SB(0, 0), b2); PG8_STAGE_B(PG8_SB(0, 1), b2 + hstepB); PG8_STAGE_A(PG8_SA(0, 0), a2, wA0);
            if (after_epi) { if constexpr (Epi::NSTORE >= 16) PG8_WAIT_V(24); else PG8_WAIT_V(16); } else PG8_WAIT_V(8);
            PG8_WAIT_L(0); PG8_BAR; if (!half) { PG8_MMA(1, 0, At, B0); PG8_MMA(1, 1, At, B1); } PG8_BAR; PG8_SCHED;
            PG8_LDB(B0, 1, 0); PG8_LDB(B1, 1, 1); PG8_SCHED; PG8_LDA(At, 1, 0); PG8_STAGE_A(PG8_SA(0, 1), a2, wA1);
            PG8_WAIT_V(8); PG8_WAIT_L(0); PG8_BAR; PG8_MMA(0, 0, At, B0); PG8_MMA(0, 1, At, B1); PG8_BAR; PG8_SCHED;
            PG8_LDA(At, 1, 1); PG8_STAGE_B(PG8_SB(1, 0), b3); PG8_STAGE_B(PG8_SB(1, 1), b3 + hstepB); PG8_STAGE_A(PG8_SA(1, 0), a3, wA0);
            PG8_WAIT_V(8); PG8_WAIT_L(0); PG8_BAR; if (!half) { PG8_MMA(1, 0, At, B0); PG8_MMA(1, 1, At, B1); } PG8_BAR; PG8_SCHED;
        }
        if constexpr (ALIGN_EPI) { if (wr == 0) PG8_BAR; }
        E(acc, cur, wr, wc, fr, fq);
        if (!has_next) break;
#pragma unroll
        for (int a = 0; a < 2; ++a)
#pragma unroll
            for (int b = 0; b < 2; ++b)
#pragma unroll
                for (int m = 0; m < 4; ++m)
#pragma unroll
                    for (int n = 0; n < 2; ++n) acc[a][b][m][n] = (f32x4){0.f, 0.f, 0.f, 0.f};
        prev_half = half; cur = nxt; cA = nA; cB = nB; ++ui;
#pragma unroll
        for (int h = 0; h < 2; ++h)
#pragma unroll
            for (int i = 0; i < 2; ++i) vA[h][i] = nvA[h][i];
        if constexpr (ALIGN_EPI) { if (wr == 1) PG8_BAR; }
    }
    PG8_WAIT_V(0);
    if constexpr (!ALIGN_EPI) { if (wr == 0) PG8_BAR; }
    PG8_BAR;
#undef PG8_SA
#undef PG8_SB
#undef PG8_STAGE_A
#undef PG8_STAGE_B
#undef PG8_LDA
#undef PG8_LDB
#undef PG8_MMA
#undef PG8_WAIT_V
#undef PG8_WAIT_L
#undef PG8_BAR
#undef PG8_SCHED
}
}
namespace attn {
using bf16x8 = __attribute__((ext_vector_type(8))) short;
using s16x4 = __attribute__((ext_vector_type(4))) short;
using f32x16 = __attribute__((ext_vector_type(16))) float;
using u32x4 = __attribute__((ext_vector_type(4))) unsigned;
constexpr int NW = 8, QBLK = 32, QB = 256, KVBLK = 64, NQB = SEQ / QB;
constexpr int KSLOT = 12288, VSLOT = 8192, NKS = 4, NVS = 3;
constexpr int LDS_K = 0, LDS_V = NKS * KSLOT, LDS_WS = LDS_V + NVS * VSLOT, LDS_OST = LDS_WS + NW * 256, LDS_BYTES = LDS_OST + NW * 4096;
__device__ __forceinline__ int crow(int r, int hi) { return (r & 3) + 8 * (r >> 2) + 4 * hi; }
#define SBAR() __builtin_amdgcn_sched_barrier(0)
__device__ __forceinline__ void cmask(f32x16& p0, f32x16& p1, int jb, int qrel, int hi) {
    const float NEG = -INFINITY; const int d = qrel - 64 * jb - 4 * hi;
#pragma unroll
    for (int r = 0; r < 16; ++r) { const int cr = (r & 3) + 8 * (r >> 2); if (cr > d) p0[r] = NEG; if (cr + 32 > d) p1[r] = NEG; }
}
__device__ __forceinline__ void glds16(unsigned voff, const void* sbase, unsigned lds_dst) { unsigned keep;
    asm volatile("s_mov_b32 %0, m0\n\ts_mov_b32 m0, %3\n\ts_nop 0\n\tglobal_load_lds_dwordx4 %1, %2\n\ts_mov_b32 m0, %0" : "=&s"(keep) : "v"(voff), "s"(sbase), "s"(lds_dst) : "memory"); }
typedef float f32x2_t __attribute__((ext_vector_type(2))); typedef __bf16 bf16x2_t __attribute__((ext_vector_type(2)));
__device__ __forceinline__ unsigned cvtpk_s(float lo, float hi) { f32x2_t v = {lo, hi}; bf16x2_t b = __builtin_convertvector(v, bf16x2_t); return __builtin_bit_cast(unsigned, b); }
#define WAIT_BAR(N) asm volatile("s_waitcnt vmcnt(" #N ") lgkmcnt(0)\n\ts_barrier" ::: "memory")
__device__ __forceinline__ void wait_bar_n(int n) { if (n >= 3) WAIT_BAR(3); else if (n == 2) WAIT_BAR(2); else if (n == 1) WAIT_BAR(1); else WAIT_BAR(0); }
typedef __attribute__((address_space(3))) const char* lds_cptr;
typedef short v4i16_t __attribute__((ext_vector_type(4)));
#define KFR(kp, i) (*(const __attribute__((address_space(3))) bf16x8*)((kp) + ((i) >> 1) * 2048 + ((i) & 1) * 512))
__device__ __forceinline__ s16x4 vtr(lds_cptr p) { return __builtin_bit_cast(s16x4, __builtin_amdgcn_ds_read_tr16_b64_v4i16((__attribute__((address_space(3))) v4i16_t*)p)); }
__device__ __forceinline__ void pv(f32x16* o, int vb, bf16x8 pa0, bf16x8 pa1, bf16x8 pa2, bf16x8 pa3) {
#pragma unroll
    for (int d0 = 0; d0 < 2; ++d0) { s16x4 lo[4], hi[4];
#pragma unroll
        for (int ks = 0; ks < 4; ++ks) {
            asm volatile("ds_read_b64_tr_b16 %0,%1 offset:%c2" : "=&v"(lo[ks]) : "v"(vb), "i"(d0 * 4096 + ks * 1024) : "memory");
            asm volatile("ds_read_b64_tr_b16 %0,%1 offset:%c2" : "=&v"(hi[ks]) : "v"(vb), "i"(d0 * 4096 + ks * 1024 + 512) : "memory"); }
        asm volatile("s_waitcnt lgkmcnt(0)" ::: "memory"); SBAR();
#define PK(k) (bf16x8){lo[k][0], lo[k][1], lo[k][2], lo[k][3], hi[k][0], hi[k][1], hi[k][2], hi[k][3]}
        o[d0] = __builtin_amdgcn_mfma_f32_32x32x16_bf16(pa0, PK(0), o[d0], 0, 0, 0);
        o[d0] = __builtin_amdgcn_mfma_f32_32x32x16_bf16(pa1, PK(1), o[d0], 0, 0, 0);
        o[d0] = __builtin_amdgcn_mfma_f32_32x32x16_bf16(pa2, PK(2), o[d0], 0, 0, 0);
        o[d0] = __builtin_amdgcn_mfma_f32_32x32x16_bf16(pa3, PK(3), o[d0], 0, 0, 0);
#undef PK
    }
}
template <int THRL>
__device__ __forceinline__ void attn_unit(int b, int h, int qb, const bf16_t* Q, const bf16_t* __restrict__ KVB, const bf16_t* __restrict__ KR, const float* __restrict__ CS, bf16_t* O, char* shm) {
    const int tid = threadIdx.x, lane = tid & 63, r32 = lane & 31, hi = lane >> 5; const int wid = __builtin_amdgcn_readfirstlane(tid >> 6);
    const long rowbase = (long)b * SEQ; const int q0 = qb * QB;
    const unsigned char* Qw = (const unsigned char*)Q + (rowbase + q0 + wid * QBLK) * QP + h * DQK;
    const bf16_t* Kh = KVB + rowbase * KVP + h * 128; const bf16_t* KRb = KR + rowbase * 32;
    const unsigned lds0 = (unsigned)(uintptr_t)shm;
    float* wsf = (float*)(shm + LDS_WS) + wid * 64;
    const unsigned koff = (unsigned)(lane * KVP + wid * 8) * 2u;
    const unsigned roff = (unsigned)(lane * 32 + (wid & 3) * 8) * 2u;
    const unsigned voff = (unsigned)(64 + (16 * (wid & 3) + (lane >> 2)) * KVP + (wid >> 2) * 32 + (lane & 3) * 8) * 2u;
    const unsigned kdst = lds0 + LDS_K + wid * 1024, rdst = lds0 + LDS_K + (8 + (wid & 3)) * 1024, vdst = lds0 + LDS_V + wid * 1024;
    const int nkd = (wid < 4) ? 2 : 1;
#define DMA_K(t) do { glds16(koff, Kh + (long)(t) * KVBLK * KVP, (unsigned)__builtin_amdgcn_readfirstlane(kdst + ((t) & 3) * KSLOT)); \
        if (wid < 4) glds16(roff, KRb + (long)(t) * KVBLK * 32, (unsigned)__builtin_amdgcn_readfirstlane(rdst + ((t) & 3) * KSLOT)); } while (0)
#define DMA_V(t, so) glds16(voff, Kh + (long)(t) * KVBLK * KVP, (unsigned)__builtin_amdgcn_readfirstlane(vdst + (so)))
    const int vb0 = (int)(lds0 + LDS_V) + ((lane >> 4) & 1) * 32 + (lane & 3) * 8 + (4 * hi + ((lane & 15) >> 2)) * 64;
    const lds_cptr shm3 = (lds_cptr)shm; const lds_cptr kp0 = shm3 + LDS_K + hi * 1024 + r32 * 16;
    const lds_cptr vp0 = shm3 + LDS_V + ((lane >> 4) & 1) * 32 + (lane & 3) * 8 + (4 * hi + ((lane & 15) >> 2)) * 64;
    const int NT = (q0 + QB) / KVBLK;
    DMA_K(0); DMA_V(0, 0); DMA_K(1); DMA_V(1, VSLOT); DMA_K(2); DMA_K(3);
    bf16x8 qr[6];
    {
        pg8::u32x2 qraw[6];
#pragma unroll
        for (int d0 = 0; d0 < 6; ++d0) qraw[d0] = *reinterpret_cast<const pg8::u32x2*>(Qw + (long)r32 * QP + d0 * 16 + hi * 8);
        const float* csp = CS + (size_t)(rowbase + q0 + wid * QBLK + r32) * 32 + 8 * hi;
        const f32x4 ca = *(const f32x4*)csp, cb = *(const f32x4*)(csp + 4), sa = *(const f32x4*)(csp + 16), sb = *(const f32x4*)(csp + 20);
#pragma unroll
        for (int d0 = 0; d0 < 4; ++d0) { const f32x4 a = unpack_f8x4(qraw[d0].x) * F8IS, b2 = unpack_f8x4(qraw[d0].y) * F8IS;
            qr[d0] = __builtin_bit_cast(bf16x8, (u32x4){cvtpk_s(a[0], a[1]), cvtpk_s(a[2], a[3]), cvtpk_s(b2[0], b2[1]), cvtpk_s(b2[2], b2[3])}); }
        const f32x4 x1a = unpack_f8x4(qraw[4].x) * F8IS, x1b = unpack_f8x4(qraw[4].y) * F8IS, x2a = unpack_f8x4(qraw[5].x) * F8IS, x2b = unpack_f8x4(qraw[5].y) * F8IS;
        const f32x4 y1a = x1a * ca - x2a * sa, y1b = x1b * cb - x2b * sb, y2a = x1a * sa + x2a * ca, y2b = x1b * sb + x2b * cb;
        qr[4] = __builtin_bit_cast(bf16x8, (u32x4){cvtpk_s(y1a[0], y1a[1]), cvtpk_s(y1a[2], y1a[3]), cvtpk_s(y1b[0], y1b[1]), cvtpk_s(y1b[2], y1b[3])});
        qr[5] = __builtin_bit_cast(bf16x8, (u32x4){cvtpk_s(y2a[0], y2a[1]), cvtpk_s(y2a[2], y2a[3]), cvtpk_s(y2b[0], y2b[1]), cvtpk_s(y2b[2], y2b[3])}); }
    float mhat = 0.f, l_reg = 0.f; f32x16 o[2]; o[0] = f32x16{}; o[1] = f32x16{}; f32x16 negm = f32x16{}; asm volatile("" : "+v"(negm));
    const int qrel = wid * QBLK + r32;
    bool resc = false;
    f32x16 pA0, pA1, pB0, pB1;
    WAIT_BAR(0);
    { const lds_cptr kp_ = kp0;
#pragma unroll
      for (int d0 = 0; d0 < 6; ++d0) { const bf16x8 b0 = KFR(kp_, 2 * d0), b1 = KFR(kp_, 2 * d0 + 1);
          pA0 = __builtin_amdgcn_mfma_f32_32x32x16_bf16(b0, qr[d0], d0 ? pA0 : negm, 0, 0, 0); pA1 = __builtin_amdgcn_mfma_f32_32x32x16_bf16(b1, qr[d0], d0 ? pA1 : negm, 0, 0, 0); }
      if (NT == 4) cmask(pA0, pA1, 0, qrel, hi);
      float a = fmaxf(fmaxf(pA0[0], pA0[1]), pA1[0]), bb = fmaxf(fmaxf(pA0[2], pA0[3]), pA1[1]); a = fmaxf(fmaxf(a, pA1[2]), pA1[3]);
#pragma unroll
      for (int r = 4; r < 16; r += 4) { a = fmaxf(fmaxf(a, pA0[r]), pA0[r + 1]); bb = fmaxf(fmaxf(bb, pA0[r + 2]), pA0[r + 3]); a = fmaxf(fmaxf(a, pA1[r]), pA1[r + 1]); bb = fmaxf(fmaxf(bb, pA1[r + 2]), pA1[r + 3]); }
      float rm = fmaxf(a, bb); { auto rr = __builtin_amdgcn_permlane32_swap(__float_as_uint(rm), __float_as_uint(rm), false, false); rm = fmaxf(__uint_as_float(rr[0]), __uint_as_float(rr[1])); }
      mhat = rm;
#pragma unroll
      for (int r = 0; r < 16; ++r) { pA0[r] = __builtin_amdgcn_exp2f(pA0[r] - rm); pA1[r] = __builtin_amdgcn_exp2f(pA1[r] - rm); }
#pragma unroll
      for (int r = 0; r < 16; ++r) negm[r] = -mhat;
      asm volatile("" : "+v"(negm)); }
    int vs_prev = 0, vs_cur = VSLOT, vs_next = 2 * VSLOT;
#define ROTV() do { const int t_ = vs_prev; vs_prev = vs_cur; vs_cur = vs_next; vs_next = t_; } while (0)
    bf16x8 kq0, kq1, kq2, kq3;
    { const lds_cptr kp_ = kp0 + KSLOT; kq0 = KFR(kp_, 0); kq1 = KFR(kp_, 1); kq2 = KFR(kp_, 2); kq3 = KFR(kp_, 3); }
    WAIT_BAR(0);
    bf16x8 va, vb_, vc; u32x4 pw0, pw1, pw2, pw3;
#define RESC() do { if (resc) { asm volatile("s_waitcnt lgkmcnt(0)" ::: "memory"); \
      _Pragma("unroll") for (int d_ = 0; d_ < 2; ++d_) _Pragma("unroll") for (int r = 0; r < 16; ++r) o[d_][r] *= wsf[crow(r, hi)]; } } while (0)
#define PKW(P, B) cvtpk_s(P[B], P[B + 1])
#define PAF(k) __builtin_bit_cast(bf16x8, pw##k)
#define PIN(x) asm volatile("" : "+v"(x))
#define MX3(a, b, c) __builtin_fmaxf(__builtin_fmaxf((a), (b)), (c))
#define MF(a, b, c) __builtin_amdgcn_mfma_f32_32x32x16_bf16(a, b, c, 0, 0, 0)
#define GAPA(MFS, A0, A1, A2, A3, W0, W1, PW) do { MFS; sacc += A0; sacc += A1; sacc += A2; sacc += A3; PIN(sacc); W0; W1; PIN(PW); SBAR(); } while (0)
#define EX(v) __builtin_amdgcn_exp2f(v)
#define GAPB(MFS, X, B) do { MFS; X[B] = EX(X[B]); X[B + 1] = EX(X[B + 1]); X[B + 2] = EX(X[B + 2]); X[B + 3] = EX(X[B + 3]); PIN(X); SBAR(); } while (0)
#define VLD(dst, i) do { const s16x4 lo_ = vtr(vp_ + (((i) >> 2) * 4096 + ((i) & 3) * 1024)), hi_ = vtr(vp_ + (((i) >> 2) * 4096 + ((i) & 3) * 1024 + 512)); \
        dst = (bf16x8){lo_[0], lo_[1], lo_[2], lo_[3], hi_[0], hi_[1], hi_[2], hi_[3]}; } while (0)
#define KRD(G, j) do { if (G) { if ((j) == 0) kq0 = KFR(kn_, 0); else if ((j) == 1) kq1 = KFR(kn_, 1); else if ((j) == 2) kq2 = KFR(kn_, 2); else kq3 = KFR(kn_, 3); } } while (0)
#define STEP(C0, C1, P0, P1, t, GK, GV, GL, MASK) do { SBAR(); \
    const lds_cptr vp_ = vp0 + vs_prev; const lds_cptr kp_ = kp0 + ((t) & 3) * KSLOT; const lds_cptr kn_ = kp0 + (((t) + 1) & 3) * KSLOT; \
    float sacc = (P0[0] + P0[1]); \
    GAPA(C0 = MF(kq0, qr[0], negm), P0[2], P0[3], P0[4], P0[5],     pw0[0] = PKW(P0, 0), pw0[1] = PKW(P0, 2), pw0); kq0 = KFR(kp_, 4); SBAR(); \
    GAPA(C1 = MF(kq1, qr[0], negm), P0[6], P0[7], P0[8], P0[9],     pw0[2] = PKW(P0, 4), pw0[3] = PKW(P0, 6), pw0); kq1 = KFR(kp_, 5); SBAR(); \
    GAPA(C0 = MF(kq2, qr[1], C0),   P0[10], P0[11], P0[12], P0[13], pw1[0] = PKW(P0, 8), pw1[1] = PKW(P0, 10), pw1); kq2 = KFR(kp_, 6); SBAR(); \
    GAPA(C1 = MF(kq3, qr[1], C1),   P0[14], P0[15], P1[0], P1[1],   pw1[2] = PKW(P0, 12), pw1[3] = PKW(P0, 14), pw1); kq3 = KFR(kp_, 7); SBAR(); \
    GAPA(C0 = MF(kq0, qr[2], C0),   P1[2], P1[3], P1[4], P1[5],     pw2[0] = PKW(P1, 0), pw2[1] = PKW(P1, 2), pw2); kq0 = KFR(kp_, 8); SBAR(); \
    GAPA(C1 = MF(kq1, qr[2], C1),   P1[6], P1[7], P1[8], P1[9],     pw2[2] = PKW(P1, 4), pw2[3] = PKW(P1, 6), pw2); kq1 = KFR(kp_, 9); SBAR(); \
    GAPA(C0 = MF(kq2, qr[3], C0),   P1[10], P1[11], P1[12], P1[13], pw3[0] = PKW(P1, 8), pw3[1] = PKW(P1, 10), pw3); kq2 = KFR(kp_, 10); SBAR(); \
    GAPA(C1 = MF(kq3, qr[3], C1),   P1[14], P1[15], 0.f, 0.f,       pw3[2] = PKW(P1, 12), pw3[3] = PKW(P1, 14), pw3); kq3 = KFR(kp_, 11); SBAR(); \
    C0 = MF(kq0, qr[4], C0); VLD(va, 0); SBAR(); C1 = MF(kq1, qr[4], C1); VLD(vb_, 4); SBAR(); C0 = MF(kq2, qr[5], C0); VLD(vc, 1); SBAR(); C1 = MF(kq3, qr[5], C1); SBAR(); \
    l_reg += sacc; \
    if (GK) { DMA_K((t) + 3); } if (GV) { DMA_V((t) + 1, vs_next); } \
    if (MASK) { const int jb_ = (t) - (NT - 4); if (jb_ >= 0) cmask(C0, C1, jb_, qrel, hi); } \
    if (THRL >= 0) { float a = MX3(C0[0], C0[1], C1[0]), b_ = MX3(C0[2], C0[3], C1[1]); a = MX3(a, C1[2], C1[3]); \
      _Pragma("unroll") for (int r = 4; r < 16; r += 4) { a = MX3(a, C0[r], C0[r + 1]); b_ = MX3(b_, C0[r + 2], C0[r + 3]); a = MX3(a, C1[r], C1[r + 1]); b_ = MX3(b_, C1[r + 2], C1[r + 3]); } \
      float rm = __builtin_fmaxf(a, b_); { auto rr = __builtin_amdgcn_permlane32_swap(__float_as_uint(rm), __float_as_uint(rm), false, false); rm = __builtin_fmaxf(__uint_as_float(rr[0]), __uint_as_float(rr[1])); } \
      resc = false; \
      if (__builtin_expect(__any(rm > (float)THRL), 0)) { const float dl = __builtin_fmaxf(rm, 0.f); mhat += dl; \
        _Pragma("unroll") for (int r = 0; r < 16; ++r) { C0[r] -= dl; C1[r] -= dl; } \
        _Pragma("unroll") for (int r = 0; r < 16; ++r) negm[r] = -mhat; asm volatile("" : "+v"(negm)); \
        const float f = __builtin_amdgcn_exp2f(-dl); l_reg *= f; if (hi == 0) wsf[r32] = f; resc = true; } } \
    else {     \
      float rs_ = sacc; { auto rr = __builtin_amdgcn_permlane32_swap(__float_as_uint(rs_), __float_as_uint(rs_), false, false); rs_ = __uint_as_float(rr[0]) + __uint_as_float(rr[1]); } \
      resc = false; \
      if (__builtin_expect(__any(rs_ > 16777216.f), 0)) { const float dl = (rs_ > 16777216.f) ? (float)(((int)(__float_as_uint(rs_) >> 23) & 255) - 127) : 0.f; mhat += dl; \
        _Pragma("unroll") for (int r = 0; r < 16; ++r) { C0[r] -= dl; C1[r] -= dl; } \
        _Pragma("unroll") for (int r = 0; r < 16; ++r) negm[r] = -mhat; asm volatile("" : "+v"(negm)); \
        const float f = __builtin_amdgcn_exp2f(-dl); l_reg *= f; if (hi == 0) wsf[r32] = f; resc = true; } } \
    SBAR(); \
    GAPB(o[0] = MF(PAF(0), va, o[0]), C0, 0);  VLD(va, 5); SBAR(); \
    GAPB(o[1] = MF(PAF(0), vb_, o[1]), C0, 4); VLD(vb_, 2); SBAR(); \
    GAPB(o[0] = MF(PAF(1), vc, o[0]), C0, 8);  VLD(vc, 6); KRD(GL, 0); SBAR(); \
    GAPB(o[1] = MF(PAF(1), va, o[1]), C0, 12); VLD(va, 3); KRD(GL, 1); SBAR(); \
    GAPB(o[0] = MF(PAF(2), vb_, o[0]), C1, 0); VLD(vb_, 7); KRD(GL, 2); SBAR(); \
    GAPB(o[1] = MF(PAF(2), vc, o[1]), C1, 4);  KRD(GL, 3); SBAR(); \
    GAPB(o[0] = MF(PAF(3), va, o[0]), C1, 8); \
    GAPB(o[1] = MF(PAF(3), vb_, o[1]), C1, 12); \
    } while (0)
    int t = 1;
    for (; t + 5 < NT; t += 2) {
        STEP(pB0, pB1, pA0, pA1, t, true, true, true, false);         if (wid < 4) WAIT_BAR(3); else WAIT_BAR(2); RESC(); ROTV();
        STEP(pA0, pA1, pB0, pB1, t + 1, true, true, true, false);     if (wid < 4) WAIT_BAR(3); else WAIT_BAR(2); RESC(); ROTV();
    }
#define ENDW(tt) wait_bar_n(((tt) + 2 < NT) ? ((((tt) + 3 < NT) ? nkd : 0) + 1) : 0)
    for (; t + 1 < NT; t += 2) {
        STEP(pB0, pB1, pA0, pA1, t, (t + 3 < NT), (t + 1 < NT), (t + 1 < NT), true);         ENDW(t);     RESC(); ROTV();
        STEP(pA0, pA1, pB0, pB1, t + 1, (t + 4 < NT), (t + 2 < NT), (t + 2 < NT), true);     ENDW(t + 1); RESC(); ROTV();
    }
    STEP(pB0, pB1, pA0, pA1, NT - 1, false, false, false, true); RESC();
    { float sacc = pB0[0] + pB0[1];
#pragma unroll
      for (int r = 2; r < 16; ++r) sacc += pB0[r];
#pragma unroll
      for (int r = 0; r < 16; ++r) sacc += pB1[r];
      l_reg += sacc;
      pw0 = (u32x4){PKW(pB0, 0), PKW(pB0, 2), PKW(pB0, 4), PKW(pB0, 6)}; pw1 = (u32x4){PKW(pB0, 8), PKW(pB0, 10), PKW(pB0, 12), PKW(pB0, 14)};
      pw2 = (u32x4){PKW(pB1, 0), PKW(pB1, 2), PKW(pB1, 4), PKW(pB1, 6)}; pw3 = (u32x4){PKW(pB1, 8), PKW(pB1, 10), PKW(pB1, 12), PKW(pB1, 14)};
      SBAR(); pv(o, vb0 + vs_cur, PAF(0), PAF(1), PAF(2), PAF(3)); }
#undef PKW
#undef PAF
#undef PIN
#undef MX3
#undef MF
#undef GAPA
#undef GAPB
#undef EX
#undef VLD
#undef KRD
#undef STEP
#undef ENDW
    { auto rr = __builtin_amdgcn_permlane32_swap(__float_as_uint(l_reg), __float_as_uint(l_reg), false, false); l_reg = __uint_as_float(rr[0]) + __uint_as_float(rr[1]); }
    if (hi == 0) wsf[32 + r32] = l_reg; asm volatile("s_waitcnt lgkmcnt(0)" ::: "memory");
    float rli[16];
#pragma unroll
    for (int r = 0; r < 16; ++r) rli[r] = __builtin_amdgcn_rcpf(wsf[32 + crow(r, hi)]);
    bf16_t* Ow = O + (rowbase + q0 + wid * QBLK) * DM + h * DV;
    { bf16_t* stg = (bf16_t*)(shm + LDS_OST) + wid * 2048;
#pragma unroll
      for (int r = 0; r < 16; ++r) { const int orow = crow(r, hi);
#pragma unroll
          for (int d0 = 0; d0 < 2; ++d0) stg[orow * 64 + d0 * 32 + r32] = f2bf(o[d0][r] * rli[r]); }
      asm volatile("s_waitcnt lgkmcnt(0)" ::: "memory");
#pragma unroll
      for (int i = 0; i < 4; ++i) { const int row = i * 8 + (lane >> 3), ch = lane & 7; const u32x4 v = *(const u32x4*)(stg + row * 64 + ch * 8); *(u32x4*)(Ow + (long)row * DM + ch * 8) = v; } }
    asm volatile("s_waitcnt lgkmcnt(0)\n\ts_barrier" ::: "memory");
#undef DMA_K
#undef DMA_V
#undef RESC
#undef ROTV
}
template <int THRL = 8>
__device__ __forceinline__ void attn_phase(char* lds, const bf16_t* Q, const bf16_t* KVB, const bf16_t* KR, const float* CS, bf16_t* O, int vcu, int G) {
    for (int hh = vcu; hh < BATCH * NH * 2; hh += G) {
        const int xg = hh >> 5, g = (hh >> 3) & 3, j = hh & 7;
#pragma unroll 1
        for (int i = 0; i < 8; ++i) { const int bh = xg * 16 + (i >> 1) * 4 + g; const int qb = (i & 1) ? 15 - j : j; attn_unit<THRL>(bh / NH, bh % NH, qb, Q, KVB, KR, CS, O, lds); }
    }
}
#undef SBAR
#undef WAIT_BAR
#undef KFR
}
constexpr int NWAVES = 8;
constexpr int RING_OFF = 0, RING_BYTES = 131072;
constexpr int ROWTAB_OFF = 131072;
constexpr int TB_OFF = ROWTAB_OFF + 4096;
constexpr int MISC_OFF = LN1_LDS_BYTES;
constexpr int LDS_BYTES = MISC_OFF + 256;
static_assert(TB_OFF + 256 <= MISC_OFF && attn::LDS_BYTES <= RING_BYTES && LDS_BYTES <= 160 * 1024, "LDS map");
#define GAS __attribute__((address_space(1)))
typedef GAS unsigned gu32;
#define RLX_AGENT __ATOMIC_RELAXED, __HIP_MEMORY_SCOPE_AGENT
constexpr int CW_BAR = 4096;

#define XB_TMO      128
#define XB_XCNT(j)  (256  + 64 * (j))
#define XB_XSUB(j)  (1280 + 64 * (j))
#define XB_XGEN(j)  (2304 + 64 * (j))
#define XB_TOP      3328
#define XB_TOPGEN   3392
#define XCD_BAR_WORDS 3456
#define XB_SPIN_CAP (1u << 18)
static_assert((CW_BAR + XCD_BAR_WORDS) * 4 <= (int)CTL_ZERO_BYTES && (CW_CNT + 128) * 4 <= CW_BAR * 4, "control words inside the per-call memset");
__device__ __forceinline__ unsigned xb_ld(unsigned* p)              { return __hip_atomic_load(p, __ATOMIC_RELAXED, __HIP_MEMORY_SCOPE_AGENT); }
__device__ __forceinline__ unsigned xb_add(unsigned* p, unsigned v) { return __hip_atomic_fetch_add(p, v, __ATOMIC_RELAXED, __HIP_MEMORY_SCOPE_AGENT); }
__device__ __forceinline__ unsigned xb_xcc_id() { return (unsigned)__builtin_amdgcn_s_getreg((3 << 11) | 20) & 0xFu; }
#define XB_SPIN(cond, bar) do { unsigned _sp = 0; while (cond) { __builtin_amdgcn_s_sleep(1); \
    if ((++_sp & 255u) == 0u) { if (xb_ld(&(bar)[XB_TMO])) break; if (_sp > XB_SPIN_CAP) { atomicAdd(&(bar)[XB_TMO], 1u); break; } } } } while (0)
struct XcdBarrier { unsigned* bar; unsigned x; volatile LAS unsigned* st; };
__device__ __forceinline__ XcdBarrier xcd_barrier_post(unsigned* bar, volatile LAS unsigned* st) {
    XcdBarrier b; b.bar = bar; b.x = xb_xcc_id(); b.st = st;
    if (threadIdx.x == 0) (void)xb_add(&bar[XB_XCNT(b.x)], 1u);
    return b;
}
__device__ __forceinline__ void xcd_barrier_complete(unsigned* bar, unsigned x, unsigned& nloc, unsigned& nx) {
    const unsigned G = gridDim.x * gridDim.y * gridDim.z;
    unsigned sum, cnt, mine, sp = 0u;
    for (;;) {
        sum = 0u; cnt = 0u; mine = 0u;
#pragma unroll
        for (unsigned j = 0; j < 16; ++j) { const unsigned c = xb_ld(&bar[XB_XCNT(j)]); sum += c; cnt += (c > 0u) ? 1u : 0u; mine = (j == x) ? c : mine; }
        if (sum == G) break;
        __builtin_amdgcn_s_sleep(1);
        if ((++sp & 255u) == 0u) { if (xb_ld(&bar[XB_TMO])) break; if (sp > XB_SPIN_CAP) { atomicAdd(&bar[XB_TMO], 1u); break; } }
    }
    nloc = mine > 0u ? mine : 1u; nx = cnt > 0u ? cnt : 1u;
}
__device__ __forceinline__ void xcd_barrier(const XcdBarrier& b) {
    asm volatile("s_waitcnt vmcnt(0)" ::: "memory");
    __syncthreads();
    if (threadIdx.x == 0) {
        unsigned* bar = b.bar;
        __builtin_amdgcn_s_waitcnt(0);
        unsigned nloc = b.st[0], nx = b.st[1];
        if (nloc == 0u) { xcd_barrier_complete(bar, b.x, nloc, nx); b.st[0] = nloc; b.st[1] = nx; }
        const unsigned old = xb_add(&bar[XB_XSUB(b.x)], 1u);
        const unsigned gen = old / nloc;
        if (old + 1u == (gen + 1u) * nloc) {
            __builtin_amdgcn_fence(__ATOMIC_RELEASE, "agent");
            asm volatile("s_waitcnt vmcnt(0)" ::: "memory");
            const unsigned og = xb_add(&bar[XB_TOP], 1u);
            const unsigned tg = og / nx;
            if (og + 1u == (tg + 1u) * nx) xb_add(&bar[XB_TOPGEN], 1u);
            else XB_SPIN(xb_ld(&bar[XB_TOPGEN]) == tg, bar);
            __builtin_amdgcn_fence(__ATOMIC_ACQUIRE, "agent");
            xb_add(&bar[XB_XGEN(b.x)], 1u);
            asm volatile("s_waitcnt vmcnt(0)" ::: "memory");
        } else {
            XB_SPIN(xb_ld(&bar[XB_XGEN(b.x)]) == gen, bar);
            __builtin_amdgcn_fence(__ATOMIC_ACQUIRE, "agent");
            asm volatile("s_waitcnt vmcnt(0)" ::: "memory");
        }
    }
    __syncthreads();
}

#ifndef MK_MSPLIT
#define MK_MSPLIT 1
#endif
constexpr int ROWTAB_OFF_ = 131072, TB_OFF_ = 131072 + 4096;
template <bool M1>
__device__ __forceinline__ void moe_gemm(LAS unsigned char* lds, int layer, int G, int c, const unsigned* cnt, const int* list, const bf16_t* A, const bf16_t* W, bf16_t* HE, bf16_t* Y2, int nostore = 0) {
    const int tid = threadIdx.x;
    LAS int* tb = (LAS int*)(lds + TB_OFF_); LAS int* rowtab = (LAS int*)(lds + ROWTAB_OFF_);
    if (tid < 64) { const int cn = (tid < 32) ? (int)cnt[tid] : 0; const int tiles = (cn + 255) >> 8; int incl = tiles;
#pragma unroll
        for (int o = 1; o < 32; o <<= 1) { const int t = __shfl_up(incl, o); if (tid >= o) incl += t; }
        if (tid < 32) tb[tid] = incl - tiles; if (tid == 31) tb[32] = incl; }
    __syncthreads();
    pg8::MoeOrder<M1 ? 2 : 4, MK_MSPLIT != 0> S; S.G = G; S.c = c; S.gather = M1 ? 1 : 0; S.tb = tb; S.rowtab = rowtab; S.cnt = cnt; S.A = (const char*)A; S.lda = M1 ? DM : FF;
    S.Bt = (const char*)(W + (size_t)layer * (M1 ? (size_t)NE * 512 * DM : (size_t)NE * DM * FF)); S.bstride = M1 ? (size_t)512 * DM * 2 : (size_t)DM * FF * 2;
    if constexpr (M1) {
        pg8::Unit u;
        for (int i = 0; i < 4; ++i) { if (!S.next(i, u)) break;
            if (tid < 256) { const int tr = tid + (u.pad == 2 ? 128 : 0), r = (u.pm - tb[u.e]) * 256 + tr;
                rowtab[i * 256 + tid] = (tr < u.cnt && tr < 256) ? list[(size_t)u.e * M + r] : list[(size_t)u.e * M]; } }
        __syncthreads();
        pg8::EpiGU E{HE};
        pg8::gemm_phase<pg8::EpiGU, pg8::MoeOrder<2, MK_MSPLIT != 0>, true>(lds, DM, DM, S, E);
    } else {
        pg8::EpiStore<false, true> E{Y2, DM, nullptr, 0, F8S, nullptr, nullptr, nostore};
        pg8::gemm_phase<pg8::EpiStore<false, true>, pg8::MoeOrder<4, MK_MSPLIT != 0>, true>(lds, FF, FF, S, E);
    }
}
constexpr int NWAVES_LN = 8;
constexpr int L1M_TS = 1032;
constexpr int L1M_THI = 0, L1M_TLO = 16 * L1M_TS * 2, L1M_RED = 2 * 16 * L1M_TS * 2, L1M_LOG = L1M_RED + 8 * 16 * 48 * 4, L1M_HIST = L1M_LOG + 128 * 48 * 4, L1M_BYTES = L1M_HIST + 256;
template <bool RES_F32, bool YF8_>
__device__ __forceinline__ void rp_ln1m(LAS unsigned char* lds, int layer, const void* res, const bf16_t* ybr, const float* modv_l, const float* lng, const float* lnb,
                                        const float* w_gr, const float* b_gr, const float* w_er, const float* b_er, bf16_t* X1, bf16_t* H2,
                                        int* tok_e, float* tok_w, int* tok_t, unsigned* cnt, int* list, int noroute = 0) {
    typedef short bf16x8 __attribute__((ext_vector_type(8)));
    const int tid = threadIdx.x, lane = tid & 63, wave = __builtin_amdgcn_readfirstlane(tid >> 6), fr = lane & 15, fq = lane >> 4;
    LAS bf16_t* Thi = (LAS bf16_t*)(lds + L1M_THI); LAS bf16_t* Tlo = (LAS bf16_t*)(lds + L1M_TLO);
    LAS float* red = (LAS float*)(lds + L1M_RED); LAS float* lgt = (LAS float*)(lds + L1M_LOG); LAS unsigned* hist = (LAS unsigned*)(lds + L1M_HIST);
    if (tid < 64) hist[tid] = 0u;
    bf16x8 Whi[3][4], Wlo[3][4];
#pragma unroll
    for (int nb = 0; nb < 3; ++nb)
#pragma unroll
        for (int ks = 0; ks < 4; ++ks) { const int n = 16 * nb + fr, k0 = 128 * wave + 32 * ks + 8 * fq; float w[8];
#pragma unroll
            for (int j = 0; j < 8; ++j) w[j] = (n < 4) ? w_gr[(size_t)layer * DM * 4 + (k0 + j) * 4 + n] : ((n < NRT) ? w_er[(size_t)layer * DM * 32 + (k0 + j) * 32 + (n - 4)] : 0.f);
            unsigned h[4], l[4];
#pragma unroll
            for (int j = 0; j < 4; ++j) { h[j] = cvt_pk_bf16(w[2 * j], w[2 * j + 1]); l[j] = cvt_pk_bf16(w[2 * j] - __uint_as_float(h[j] << 16), w[2 * j + 1] - __uint_as_float(h[j] & 0xffff0000u)); }
            Whi[nb][ks] = __builtin_bit_cast(bf16x8, (pg8::u32x4){h[0], h[1], h[2], h[3]}); Wlo[nb][ks] = __builtin_bit_cast(bf16x8, (pg8::u32x4){l[0], l[1], l[2], l[3]}); }
    __syncthreads();
    const int rows_per_blk = M / gridDim.x; const int vb_ = (gridDim.x % 8 == 0) ? (int)((blockIdx.x % 8) * (gridDim.x / 8) + blockIdx.x / 8) : (int)blockIdx.x;
    const int row0 = vb_ * rows_per_blk;
    f32x4 pres[2][2][2]; pg8::u32x4 presb[2][2], pyb[2][2]; pg8::u32x2 py[2][2];
#define L1M_LOADG(gg) do { _Pragma("unroll") for (int r = 0; r < 2; ++r) { const size_t mo_ = (size_t)(row0 + 16 * (gg) + 2 * wave + r) * DM; \
        _Pragma("unroll") for (int jp = 0; jp < 2; ++jp) { const int e = 8 * lane + 512 * jp; \
            if (RES_F32) { pres[r][jp][0] = *(const f32x4*)((const float*)res + mo_ + e); pres[r][jp][1] = *(const f32x4*)((const float*)res + mo_ + e + 4); } else presb[r][jp] = *(const pg8::u32x4*)((const bf16_t*)res + mo_ + e); \
            if (YF8_) py[r][jp] = *(const pg8::u32x2*)((const unsigned char*)ybr + mo_ + e); else pyb[r][jp] = *(const pg8::u32x4*)(ybr + mo_ + e); } } } while (0)
#define L1M_BF2(lo_, hi_) ((f32x4){__uint_as_float((lo_) << 16), __uint_as_float((lo_) & 0xffff0000u), __uint_as_float((hi_) << 16), __uint_as_float((hi_) & 0xffff0000u)})
    const int ngrp = rows_per_blk / 16;
    L1M_LOADG(0);
    for (int g = 0; g < ngrp; ++g) {
        f32x4 u[2][2][2]; float mean[2], rs[2];
        { const int b = (row0 + 16 * g) / SEQ; const float* mv = modv_l + (size_t)b * 6 * DM;
#pragma unroll
          for (int r = 0; r < 2; ++r) { float s = 0.f;
#pragma unroll
            for (int jp = 0; jp < 2; ++jp)
#pragma unroll
              for (int q = 0; q < 2; ++q) { const int e = 8 * lane + 512 * jp + 4 * q;
                const f32x4 rv = RES_F32 ? pres[r][jp][q] : (q ? L1M_BF2(presb[r][jp].z, presb[r][jp].w) : L1M_BF2(presb[r][jp].x, presb[r][jp].y));
                const f32x4 yv = YF8_ ? unpack_f8x4(q ? py[r][jp].y : py[r][jp].x) * F8IS : (q ? L1M_BF2(pyb[r][jp].z, pyb[r][jp].w) : L1M_BF2(pyb[r][jp].x, pyb[r][jp].y));
                const f32x4 g1 = *(const f32x4*)(mv + 2 * DM + e);
                u[r][jp][q] = DN_ALPHA * rv + (1.f + g1) * yv; s += hsum4(u[r][jp][q]); }
            mean[r] = wave_sum(s) * (1.f / DM); } }
        if (g + 1 < ngrp) L1M_LOADG(g + 1);
#pragma unroll
        for (int r = 0; r < 2; ++r) {
            const int tr = 2 * wave + r, m = row0 + 16 * g + tr; const int b = m / SEQ; const float* mv = modv_l + (size_t)b * 6 * DM;
            float s2 = 0.f;
#pragma unroll
            for (int jp = 0; jp < 2; ++jp)
#pragma unroll
                for (int q = 0; q < 2; ++q) { u[r][jp][q] = u[r][jp][q] - mean[r]; s2 += hsum4(u[r][jp][q] * u[r][jp][q]); }
            rs[r] = 1.f / sqrtf(wave_sum(s2) * (1.f / DM) + LN_EPS);
#pragma unroll
            for (int jp = 0; jp < 2; ++jp) { const int e0 = 8 * lane + 512 * jp; unsigned xw[4], hw[4], lw[4];
#pragma unroll
                for (int q = 0; q < 2; ++q) { const int e = e0 + 4 * q;
                    const f32x4 x1 = u[r][jp][q] * rs[r] * *(const f32x4*)(lng + e) + *(const f32x4*)(lnb + e);
                    xw[2 * q] = cvt_pk_bf16(x1[0], x1[1]); xw[2 * q + 1] = cvt_pk_bf16(x1[2], x1[3]);
                    const f32x4 sh = *(const f32x4*)(mv + 3 * DM + e), sc = *(const f32x4*)(mv + 4 * DM + e);
                    const f32x4 hv = x1 * (1.f + sc) + sh;
                    hw[2 * q] = cvt_pk_bf16(hv[0], hv[1]); hw[2 * q + 1] = cvt_pk_bf16(hv[2], hv[3]);
                    lw[2 * q] = cvt_pk_bf16(hv[0] - __uint_as_float(hw[2 * q] << 16), hv[1] - __uint_as_float(hw[2 * q] & 0xffff0000u));
                    lw[2 * q + 1] = cvt_pk_bf16(hv[2] - __uint_as_float(hw[2 * q + 1] << 16), hv[3] - __uint_as_float(hw[2 * q + 1] & 0xffff0000u)); }
                *(pg8::u32x4*)(X1 + (size_t)m * DM + e0) = (pg8::u32x4){xw[0], xw[1], xw[2], xw[3]};
                *(pg8::u32x4*)(H2 + (size_t)m * DM + e0) = (pg8::u32x4){hw[0], hw[1], hw[2], hw[3]};
                *(LAS pg8::u32x4*)(Thi + tr * L1M_TS + e0) = (pg8::u32x4){hw[0], hw[1], hw[2], hw[3]};
                *(LAS pg8::u32x4*)(Tlo + tr * L1M_TS + e0) = (pg8::u32x4){lw[0], lw[1], lw[2], lw[3]}; }
        }
        __syncthreads();
        f32x4 acc[3];
#pragma unroll
        for (int nb = 0; nb < 3; ++nb) acc[nb] = (f32x4){0.f, 0.f, 0.f, 0.f};
#pragma unroll
        for (int ks = 0; ks < 4; ++ks) {
            const bf16x8 Hhi = *(const LAS bf16x8*)(Thi + fr * L1M_TS + 128 * wave + 32 * ks + 8 * fq), Hlo = *(const LAS bf16x8*)(Tlo + fr * L1M_TS + 128 * wave + 32 * ks + 8 * fq);
#pragma unroll
            for (int nb = 0; nb < 3; ++nb) {
                acc[nb] = __builtin_amdgcn_mfma_f32_16x16x32_bf16(Wlo[nb][ks], Hhi, acc[nb], 0, 0, 0);
                acc[nb] = __builtin_amdgcn_mfma_f32_16x16x32_bf16(Whi[nb][ks], Hlo, acc[nb], 0, 0, 0);
                acc[nb] = __builtin_amdgcn_mfma_f32_16x16x32_bf16(Whi[nb][ks], Hhi, acc[nb], 0, 0, 0); }
        }
#pragma unroll
        for (int nb = 0; nb < 3; ++nb) *(LAS f32x4*)(red + (wave * 16 + fr) * 48 + 16 * nb + 4 * fq) = acc[nb];
        __syncthreads();
        for (int i = tid; i < 768; i += NWAVES_LN * 64) { float s = 0.f;
#pragma unroll
            for (int w = 0; w < 8; ++w) s += red[w * 768 + i];
            lgt[g * 768 + i] = s; }
    }
    __syncthreads();
    if (tid < rows_per_blk && !noroute) {
        const int m = row0 + tid; const LAS float* lp = lgt + tid * 48;
        float gmax = lp[0] + b_gr[layer * 4 + 0]; int gi = 0; float gl[4]; gl[0] = gmax;
#pragma unroll
        for (int i = 1; i < 4; ++i) { gl[i] = lp[i] + b_gr[layer * 4 + i]; if (gl[i] > gmax) { gmax = gl[i]; gi = i; } }
        float gs = 0.f;
#pragma unroll
        for (int i = 0; i < 4; ++i) gs += __expf(gl[i] - gmax);
        const float gp = 1.f / gs;
        float v1 = -INFINITY, v2 = -INFINITY; int i1 = 0, i2 = 0;
        for (int i = 0; i < 8; ++i) { const float v = lp[4 + gi * 8 + i] + b_er[layer * 32 + gi * 8 + i];
            if (v > v1) { v2 = v1; i2 = i1; v1 = v; i1 = i; } else if (v > v2) { v2 = v; i2 = i; } }
        const float e2 = __expf(v2 - v1), w1 = gp / (1.f + e2), w2 = gp * e2 / (1.f + e2);
        const int e1i = gi * 8 + i1, e2i = gi * 8 + i2;
        tok_e[2 * m] = e1i; tok_e[2 * m + 1] = e2i; tok_w[2 * m] = w1; tok_w[2 * m + 1] = w2;
        tok_t[2 * m] = (int)__hip_atomic_fetch_add(hist + e1i, 1u, __ATOMIC_RELAXED, __HIP_MEMORY_SCOPE_WORKGROUP); tok_t[2 * m + 1] = (int)__hip_atomic_fetch_add(hist + e2i, 1u, __ATOMIC_RELAXED, __HIP_MEMORY_SCOPE_WORKGROUP);
    }
    __syncthreads();
    if (noroute) return;
    if (tid < 32) { const unsigned n = hist[tid]; hist[32 + tid] = n ? __hip_atomic_fetch_add(cnt + tid, n, __ATOMIC_RELAXED, __HIP_MEMORY_SCOPE_AGENT) : 0u; }
    __syncthreads();
    for (int i = tid; i < rows_per_blk * 2; i += NWAVES_LN * 64) { const int idx = row0 * 2 + i; const int e = tok_e[idx]; const int t = tok_t[idx] + (int)hist[32 + e]; tok_t[idx] = t; list[(size_t)e * M + t] = idx >> 1; }
}
constexpr int LNP_HALO = 15;
__device__ __forceinline__ void rp_ln2pool(LAS unsigned char* lds, int vcu, int G, int lane, int wave, const bf16_t* X1, const unsigned char* Y2, const int* tok_e, const float* tok_w, const int* tok_t, const unsigned* cnt,
                                           const float* modv_l0, const float* lng, const float* lnb, bf16_t* X2, const float* modv_l1, bf16_t* MIX) {
    LAS bf16_t* halo = (LAS bf16_t*)lds;
    const int rows_per_blk = M / G, row0 = vcu * rows_per_blk, b = row0 / SEQ;
    const bool seq_start = (row0 % SEQ) == 0;
    f32x4 lg4[4], lb4[4];
#pragma unroll
    for (int j = 0; j < 4; ++j) { lg4[j] = *(const f32x4*)(lng + 4 * lane + 256 * j); lb4[j] = *(const f32x4*)(lnb + 4 * lane + 256 * j); }
    int mybase; { const int c = (lane < 32) ? (int)cnt[lane] : 0; int pad = (c + 255) & ~255; int incl = pad;
#pragma unroll
        for (int o = 1; o < 32; o <<= 1) { const int t = __shfl_up(incl, o); if ((lane & 31) >= o) incl += t; }
        mybase = incl - pad; }
    {
        const float* mv = modv_l0 + (size_t)b * 6 * DM;
        f32x4 g2[4];
#pragma unroll
        for (int j = 0; j < 4; ++j) g2[j] = 1.f + *(const f32x4*)(mv + 5 * DM + 4 * lane + 256 * j);
        const int rrl = -LNP_HALO + wave + 8 * (lane < 18 ? lane : 17); const bool okl = (rrl < rows_per_blk) && (rrl >= 0 || !seq_start);
        const int ml = okl ? row0 + rrl : row0;
        const int e0 = tok_e[2 * ml], e1 = tok_e[2 * ml + 1]; const float wl0 = tok_w[2 * ml], wl1 = tok_w[2 * ml + 1];
        const int rl0 = __shfl(mybase, e0) + tok_t[2 * ml], rl1 = __shfl(mybase, e1) + tok_t[2 * ml + 1];
#pragma unroll 1
        for (int k = 0; k < 18; k += 2) {
            f32x4 xv[2][4], ya[2][4], yb[2][4]; float w0[2], w1[2]; int rr[2]; bool ok[2];
#pragma unroll
            for (int r = 0; r < 2; ++r) { rr[r] = -LNP_HALO + wave + 8 * (k + r); ok[r] = (rr[r] < rows_per_blk) && (rr[r] >= 0 || !seq_start);
                const size_t r0 = (size_t)__shfl(rl0, k + r), r1 = (size_t)__shfl(rl1, k + r); w0[r] = __shfl(wl0, k + r); w1[r] = __shfl(wl1, k + r);
                if (ok[r]) {
#pragma unroll
                    for (int j = 0; j < 4; ++j) { const int e = 4 * lane + 256 * j; xv[r][j] = ld_bf4(X1 + (size_t)(row0 + rr[r]) * DM + e); ya[r][j] = ld_f8x4(Y2 + r0 * DM + e); yb[r][j] = ld_f8x4(Y2 + r1 * DM + e); } } }
#pragma unroll
            for (int r = 0; r < 2; ++r) if (ok[r]) { f32x4 u[4]; float s = 0.f;
#pragma unroll
                for (int j = 0; j < 4; ++j) { u[j] = DN_ALPHA * xv[r][j] + g2[j] * (w0[r] * ya[r][j] + w1[r] * yb[r][j]); s += hsum4(u[j]); }
                const float mean = wave_sum(s) * (1.f / DM); float s2 = 0.f;
#pragma unroll
                for (int j = 0; j < 4; ++j) { u[j] = u[j] - mean; s2 += hsum4(u[j] * u[j]); }
                const float rs = 1.f / sqrtf(wave_sum(s2) * (1.f / DM) + LN_EPS);
#pragma unroll
                for (int j = 0; j < 4; ++j) { const int e = 4 * lane + 256 * j; const f32x4 o = u[j] * rs * lg4[j] + lb4[j];
                    pg8::u32x2 w; w.x = cvt_pk_bf16(o.x, o.y); w.y = cvt_pk_bf16(o.z, o.w);
                    if (rr[r] >= 0) *(pg8::u32x2*)(X2 + (size_t)(row0 + rr[r]) * DM + e) = w; else *(LAS pg8::u32x2*)(halo + (rr[r] + LNP_HALO) * DM + e) = w; } }
        }
    }
    asm volatile("s_waitcnt vmcnt(0) lgkmcnt(0)" ::: "memory");
    __syncthreads();
    {
        const float* mv = modv_l1 + (size_t)b * 6 * DM;
        const int m0 = row0 + 16 * wave, t0 = m0 % SEQ;
        f32x4 sh[4], sc[4], S[4];
#pragma unroll
        for (int j = 0; j < 4; ++j) { const int e = 4 * lane + 256 * j; sh[j] = *(const f32x4*)(mv + e); sc[j] = 1.f + *(const f32x4*)(mv + DM + e); S[j] = (f32x4){0.f, 0.f, 0.f, 0.f}; }
#define LNP_LD(dst, mrow, e) do { if ((mrow) >= row0) dst = *(const pg8::u32x2*)(X2 + (size_t)(mrow) * DM + (e)); else dst = *(const LAS pg8::u32x2*)(halo + ((mrow) - row0 + LNP_HALO) * DM + (e)); } while (0)
#define LNP_F4(u_) ((f32x4){__uint_as_float((u_).x << 16), __uint_as_float((u_).x & 0xffff0000u), __uint_as_float((u_).y << 16), __uint_as_float((u_).y & 0xffff0000u)})
#pragma unroll
        for (int j = 0; j < 4; ++j) { const int w = 2 << j, e = 4 * lane + 256 * j;
            for (int i = 1; i < w; ++i) if (t0 - i >= 0) { pg8::u32x2 v; LNP_LD(v, m0 - i, e); S[j] += LNP_F4(v) * sc[j] + sh[j]; } }
#pragma unroll 1
        for (int rb = 0; rb < 16; rb += 4) {
            pg8::u32x2 cur[4][4], lag[4][4];
#pragma unroll
            for (int r = 0; r < 4; ++r)
#pragma unroll
                for (int j = 0; j < 4; ++j) { const int w = 2 << j, e = 4 * lane + 256 * j; const int m = m0 + rb + r, t = t0 + rb + r;
                    cur[r][j] = *(const pg8::u32x2*)(X2 + (size_t)m * DM + e);
                    if (t - w + 1 >= 0) LNP_LD(lag[r][j], m - w + 1, e); else lag[r][j] = (pg8::u32x2){0u, 0u}; }
#pragma unroll
            for (int r = 0; r < 4; ++r) { const int m = m0 + rb + r, t = t0 + rb + r;
#pragma unroll
                for (int j = 0; j < 4; ++j) { const int w = 2 << j, e = 4 * lane + 256 * j;
                    const f32x4 hv = LNP_F4(cur[r][j]) * sc[j] + sh[j]; S[j] += hv;
                    const float inv = 1.f / (float)((t + 1 < w) ? (t + 1) : w);
                    st_bf4(MIX + (size_t)m * DM + e, S[j] * inv - hv);
                    if (t - w + 1 >= 0) S[j] -= LNP_F4(lag[r][j]) * sc[j] + sh[j]; }
            }
        }
#undef LNP_LD
#undef LNP_F4
    }
}
constexpr int PG_STR = 264;
constexpr int PG_LDS_BYTES = 2 * 128 * PG_STR * 2;
#define PG_BF4(u_) ((f32x4){__uint_as_float((u_).x << 16), __uint_as_float((u_).x & 0xffff0000u), __uint_as_float((u_).y << 16), __uint_as_float((u_).y & 0xffff0000u)})
template <int GI>
__device__ __forceinline__ void pg_load_rows(const bf16_t* X2, int m0, int t0, int lane, pg8::u32x2 (&cur)[16], pg8::u32x2 (&lag)[15]) {
    constexpr int w = 2 << GI; const int e = 256 * GI + 4 * lane;
#pragma unroll
    for (int r = 0; r < 16; ++r) cur[r] = *(const pg8::u32x2*)(X2 + (size_t)(m0 + r) * DM + e);
#pragma unroll
    for (int r = 0; r < w - 1; ++r) lag[r] = (t0 + r - w + 1 >= 0) ? *(const pg8::u32x2*)(X2 + (size_t)(m0 + r - w + 1) * DM + e) : (pg8::u32x2){0u, 0u};
}
template <int GI>
__device__ __forceinline__ void pg_pool(const float* mv, int t0, int lane, int wave, const pg8::u32x2 (&cur)[16], const pg8::u32x2 (&lag)[15], LAS bf16_t* MIXL) {
    constexpr int w = 2 << GI; const int e = 256 * GI + 4 * lane;
    const f32x4 sh = *(const f32x4*)(mv + e), sc = 1.f + *(const f32x4*)(mv + DM + e);
    f32x4 S = (f32x4){0.f, 0.f, 0.f, 0.f};
#pragma unroll
    for (int r = 0; r < w - 1; ++r) if (t0 + r - w + 1 >= 0) S += PG_BF4(lag[r]) * sc + sh;
#pragma unroll
    for (int r = 0; r < 16; ++r) { const f32x4 hv = PG_BF4(cur[r]) * sc + sh; S += hv; const int t = t0 + r;
        const float inv = 1.f / (float)((t + 1 < w) ? (t + 1) : w); const f32x4 mx = S * inv - hv;
        pg8::u32x2 o; o.x = cvt_pk_bf16(mx[0], mx[1]); o.y = cvt_pk_bf16(mx[2], mx[3]);
        *(LAS pg8::u32x2*)(MIXL + (16 * wave + r) * PG_STR + 4 * lane) = o;
        if (r >= w - 1) S -= PG_BF4(cur[r - w + 1 < 0 ? 0 : r - w + 1]) * sc + sh; else if (t - w + 1 >= 0) S -= PG_BF4(lag[r]) * sc + sh; }
}
template <bool OUTF8>
__device__ __forceinline__ void rp_poolgemm(LAS unsigned char* lds, int vcu, int G, const bf16_t* X2, const float* modv_l1, const bf16_t* WP, const float* pool_scale, bf16_t* YP) {
    typedef short bf16x8 __attribute__((ext_vector_type(8)));
    const int tid = threadIdx.x, lane = tid & 63, wave = __builtin_amdgcn_readfirstlane(tid >> 6), fr = lane & 15, fq = lane >> 4, wm = wave & 3, wn = wave >> 2;
    LAS bf16_t* MIXL = (LAS bf16_t*)lds; LAS bf16_t* WL = MIXL + 128 * PG_STR;
    const int row0 = vcu * (M / G), b = row0 / SEQ, m0 = row0 + 16 * wave, t0 = m0 % SEQ; const float* mv = modv_l1 + (size_t)b * 6 * DM;
    pg8::u32x2 cur[16], lag[15]; pg8::u32x4 wreg[8];
#define PG_LOADW(gg, hh) do { _Pragma("unroll") for (int i = 0; i < 8; ++i) { const int c_ = tid + 512 * i; wreg[i] = *(const pg8::u32x4*)(WP + ((size_t)((gg) * 256 + 128 * (hh) + (c_ >> 5)) * 256 + (c_ & 31) * 8)); } } while (0)
#define PG_STOREW() do { _Pragma("unroll") for (int i = 0; i < 8; ++i) { const int c_ = tid + 512 * i; *(LAS pg8::u32x4*)(WL + (c_ >> 5) * PG_STR + (c_ & 31) * 8) = wreg[i]; } } while (0)
#define PG_GEMM(gg, hh) do { f32x4 acc[2][4]; \
        _Pragma("unroll") for (int mb = 0; mb < 2; ++mb) _Pragma("unroll") for (int nb = 0; nb < 4; ++nb) acc[mb][nb] = (f32x4){0.f, 0.f, 0.f, 0.f}; \
        _Pragma("unroll") for (int ks = 0; ks < 8; ++ks) { bf16x8 bm[2], aw[4]; \
            _Pragma("unroll") for (int mb = 0; mb < 2; ++mb) bm[mb] = *(const LAS bf16x8*)(MIXL + (32 * wm + 16 * mb + fr) * PG_STR + 32 * ks + 8 * fq); \
            _Pragma("unroll") for (int nb = 0; nb < 4; ++nb) aw[nb] = *(const LAS bf16x8*)(WL + (64 * wn + 16 * nb + fr) * PG_STR + 32 * ks + 8 * fq); \
            _Pragma("unroll") for (int mb = 0; mb < 2; ++mb) _Pragma("unroll") for (int nb = 0; nb < 4; ++nb) acc[mb][nb] = __builtin_amdgcn_mfma_f32_16x16x32_bf16(aw[nb], bm[mb], acc[mb][nb], 0, 0, 0); } \
        _Pragma("unroll") for (int nb = 0; nb < 4; ++nb) { const int col = 256 * (gg) + 128 * (hh) + 64 * wn + 16 * nb + 4 * fq; const f32x4 ps = *(const f32x4*)(pool_scale + col); \
            if (OUTF8) { _Pragma("unroll") for (int mb = 0; mb < 2; ++mb) { const f32x4 v = acc[mb][nb] * ps; \
                *(unsigned*)((unsigned char*)YP + (size_t)(row0 + 32 * wm + 16 * mb + fr) * DM + col) = pack_f8x4(v[0] * F8S, v[1] * F8S, v[2] * F8S, v[3] * F8S); } } \
            else { const f32x4 va_ = acc[0][nb] * ps, vb2_ = acc[1][nb] * ps; unsigned xA = cvt_pk_bf16(va_[0], va_[1]), yA = cvt_pk_bf16(va_[2], va_[3]), xB = cvt_pk_bf16(vb2_[0], vb2_[1]), yB = cvt_pk_bf16(vb2_[2], vb2_[3]); \
                { auto r_ = __builtin_amdgcn_permlane16_swap(xA, xB, false, false); xA = r_[0]; xB = r_[1]; } { auto r_ = __builtin_amdgcn_permlane16_swap(yA, yB, false, false); yA = r_[0]; yB = r_[1]; } \
                *(pg8::u32x4*)(YP + (size_t)(row0 + 32 * wm + 16 * (fq & 1) + fr) * DM + col - ((fq & 1) ? 4 : 0)) = (pg8::u32x4){xA, yA, xB, yB}; } } } while (0)
#define PG_GROUP(gg, NEXTLOAD) do { pg_pool<gg>(mv, t0, lane, wave, cur, lag, MIXL); NEXTLOAD; \
        PG_STOREW(); PG_LOADW(gg, 1); __syncthreads(); PG_GEMM(gg, 0); __syncthreads(); \
        PG_STOREW(); if ((gg) < 3) PG_LOADW((gg) + 1, 0); __syncthreads(); PG_GEMM(gg, 1); __syncthreads(); } while (0)
    pg_load_rows<0>(X2, m0, t0, lane, cur, lag); PG_LOADW(0, 0);
    PG_GROUP(0, pg_load_rows<1>(X2, m0, t0, lane, cur, lag));
    PG_GROUP(1, pg_load_rows<2>(X2, m0, t0, lane, cur, lag));
    PG_GROUP(2, pg_load_rows<3>(X2, m0, t0, lane, cur, lag));
    PG_GROUP(3, (void)0);
#undef PG_LOADW
#undef PG_STOREW
#undef PG_GEMM
#undef PG_GROUP
}
#undef PG_BF4
template <int MAP>
__device__ __forceinline__ void conv_item(const float* W, int ldw, int K, bf16_t* WT, const float* kscale, LAS float* scr, int kb, int nb, int lane) {
    const int k0 = 64 * kb, n0 = 32 * nb;
    float v[32];
#pragma unroll
    for (int i = 0; i < 32; ++i) { const int kk = 2 * i + (lane >> 5); v[i] = W[(size_t)(k0 + kk) * ldw + n0 + (lane & 31)]; }
    if (kscale) {
#pragma unroll
        for (int i = 0; i < 32; ++i) v[i] *= kscale[k0 + 2 * i + (lane >> 5)]; }
#pragma unroll
    for (int i = 0; i < 32; ++i) scr[(2 * i + (lane >> 5)) * 33 + (lane & 31)] = v[i];
    asm volatile("s_waitcnt lgkmcnt(0)" ::: "memory");
    const int c = lane & 7;
#pragma unroll
    for (int j = 0; j < 4; ++j) { const int n = (lane >> 3) + 8 * j; const LAS float* s = scr + (8 * c) * 33 + n;
        int row;
        if (MAP == 0) row = n0 + n;
        else if (MAP == 1) { const int p = ((nb % 3) == 2) ? (8 * ((n & 15) >> 2) + 4 * (n >> 4) + (n & 3)) : n; row = n0 + p; }
        else if (MAP == 4) { const int p = (nb == 20) ? (8 * ((n & 15) >> 2) + 4 * (n >> 4) + (n & 3)) : n; row = n0 + p; }
        else { const int jj = n0 + n; row = (jj >> 2) * 8 + (jj & 3) + (MAP == 3 ? 4 : 0); }
        pg8::u32x4 o; o.x = cvt_pk_bf16(s[0 * 33], s[1 * 33]); o.y = cvt_pk_bf16(s[2 * 33], s[3 * 33]); o.z = cvt_pk_bf16(s[4 * 33], s[5 * 33]); o.w = cvt_pk_bf16(s[6 * 33], s[7 * 33]);
        *(pg8::u32x4*)(WT + (size_t)row * K + k0 + 8 * c) = o; }
    asm volatile("s_waitcnt lgkmcnt(0)" ::: "memory");
}

template <int MAP>
__device__ __forceinline__ void conv_item64(const float* W, int ldw, int K, bf16_t* WT, LAS float* scr, int kb, int nb, int lane) {
    const int k0 = 64 * kb, n0 = 64 * nb;
    f32x4 v[16];
    const float* wp = W + (size_t)(k0 + (lane >> 4)) * ldw + n0 + 4 * (lane & 15);
#pragma unroll
    for (int i = 0; i < 16; ++i) v[i] = *(const f32x4*)(wp + (size_t)(4 * i) * ldw);
#pragma unroll
    for (int i = 0; i < 16; ++i) { LAS float* sp = scr + (4 * i + (lane >> 4)) * 65 + 4 * (lane & 15); sp[0] = v[i][0]; sp[1] = v[i][1]; sp[2] = v[i][2]; sp[3] = v[i][3]; }
    asm volatile("s_waitcnt lgkmcnt(0)" ::: "memory");
    const int c = lane & 7;
#pragma unroll
    for (int j = 0; j < 8; ++j) { const int n = (lane >> 3) + 8 * j; const LAS float* s = scr + (8 * c) * 65 + n;
        int row; if (MAP == 0) row = n0 + n; else { const int jj = n0 + n; row = (jj >> 2) * 8 + (jj & 3) + (MAP == 3 ? 4 : 0); }
        pg8::u32x4 o; o.x = cvt_pk_bf16(s[0 * 65], s[1 * 65]); o.y = cvt_pk_bf16(s[2 * 65], s[3 * 65]); o.z = cvt_pk_bf16(s[4 * 65], s[5 * 65]); o.w = cvt_pk_bf16(s[6 * 65], s[7 * 65]);
        *(pg8::u32x4*)(WT + (size_t)row * K + k0 + 8 * c) = o; }
    asm volatile("s_waitcnt lgkmcnt(0)" ::: "memory");
}

struct Args { const void* in[22]; float* out; unsigned char* ws; int ph_lo, ph_hi, variant, pad; };
constexpr int NPHASE = 17;
#ifndef MK_THRL
#define MK_THRL -1
#endif
#ifndef MK_ZSPLIT
#define MK_ZSPLIT 1
#endif
#ifndef MK_FSPLIT
#define MK_FSPLIT 1
#endif
#ifndef MK_FILL_PCT
#define MK_FILL_PCT 100
#endif
#ifndef MK_YF8
#define MK_YF8 0
#endif
constexpr bool YF8 = (MK_YF8 & 1) != 0, YPF8 = (MK_YF8 & 2) != 0;

__global__ void __launch_bounds__(NWAVES * 64, 2) mk_fwd(Args args) {
    extern __shared__ __attribute__((aligned(16))) unsigned char lds_dyn[];
    LAS unsigned char* lds = (LAS unsigned char*)lds_dyn;
    const int tid = threadIdx.x, lane = tid & 63, wave = __builtin_amdgcn_readfirstlane(tid >> 6);
    const int G = gridDim.x; const int bx = blockIdx.x; const int vcu = (G % 8 == 0) ? (bx % 8) * (G / 8) + bx / 8 : bx;
    volatile LAS unsigned* MISC = (volatile LAS unsigned*)(lds + MISC_OFF);
    if (tid < 64) MISC[tid] = 0u;
    __syncthreads();
#define KA_ ((const __attribute__((address_space(4))) char*)__builtin_amdgcn_kernarg_segment_ptr())
#define ARGQ(i) (*(const __attribute__((address_space(4))) unsigned long long volatile*)(KA_ + 8 * (i)))
#define INP(T, i) ((const T*)(const __attribute__((address_space(1))) T*)ARGQ(i))
#define WSB(T, off) ((T*)(__attribute__((address_space(1))) T*)(ARGQ(23) + (unsigned long long)(off)))
#define x INP(float, 0)
#define c_in INP(float, 1)
#define positions INP(int, 2)
#define w_mod INP(float, 3)
#define b_mod INP(float, 4)
#define ln_g INP(float, 5)
#define ln_b INP(float, 6)
#define w_in INP(float, 7)
#define q_norm_g INP(float, 8)
#define kv_norm_g INP(float, 9)
#define w_uq INP(float, 10)
#define w_ukv INP(float, 11)
#define w_o INP(float, 12)
#define w_pool INP(float, 13)
#define pool_scale INP(float, 14)
#define w_gr INP(float, 15)
#define b_gr INP(float, 16)
#define w_er INP(float, 17)
#define b_er INP(float, 18)
#define w_gate INP(float, 19)
#define w_up INP(float, 20)
#define w_down INP(float, 21)
#define OUTPTR ((float*)(__attribute__((address_space(1))) float*)ARGQ(22))
#define ctl WSB(unsigned, WS_CTL)
#define modv WSB(float, WS_MODV)
#define modv0 WSB(float, WS_MODV)
#define modv1 WSB(float, WS_MODV + 8 * 6 * DM * 4)
#define WGU WSB(bf16_t, WS_WGU)
#define WD WSB(bf16_t, WS_WD)
#define WIN WSB(bf16_t, WS_WIN)
#define WUQ WSB(bf16_t, WS_WUQ)
#define WUKV WSB(bf16_t, WS_WUKV)
#define WO WSB(bf16_t, WS_WO)
#define WPOOL WSB(bf16_t, WS_WPOOL)
#define tok_e WSB(int, WS_TOK)
#define tok_w WSB(float, WS_TOK + 256 * 1024)
#define tok_t WSB(int, WS_TOK + 512 * 1024)
#define rstd WSB(float, WS_RSTD)
#define X1 WSB(bf16_t, WS_X1)
#define H2 WSB(bf16_t, WS_H2)
#define KVB WSB(bf16_t, WS_KVB)
#define Qb WSB(bf16_t, WS_Q)
#define HE WSB(bf16_t, WS_HE)
#define X2 WSB(bf16_t, WS_X2)
#define Ob WSB(bf16_t, WS_O)
#define Y2 WSB(bf16_t, WS_Y2)
#define Zb WSB(bf16_t, WS_Z)
#define Yb WSB(bf16_t, WS_Y)
#define H0 WSB(bf16_t, WS_H0)
#define KR WSB(bf16_t, WS_KR)
#define list WSB(int, WS_LIST)
#define CS WSB(float, WS_CS)
#define SSQB WSB(float, WS_SSQ)
#define MIX H2
#define YP Y2
#define X3 X1
    RowCtx R{lane, wave, vcu * NWAVES + wave, G * NWAVES};

    XcdBarrier bar = xcd_barrier_post(ctl + CW_BAR, MISC + 8);
    const int lo = args.ph_lo, hi = args.ph_hi;
#ifndef MK_CMASK
#define MK_CMASK 0x1FFFF
#endif
#define IN(k) (((MK_CMASK >> (k)) & 1) && lo <= (k) && (k) < hi)
#ifndef MK_DBLMASK
#define MK_DBLMASK 0
#endif
#define PH_REP(k) ((((MK_DBLMASK) >> (k)) & 1) ? 2 : 1)
#define INR(k) if (IN(k))
#ifndef MK_DBLBAR
#define MK_DBLBAR 0
#endif
#define SEAM(k) do { if (IN(k) && IN((k) + 1)) { xcd_barrier(bar); if (MK_DBLBAR) xcd_barrier(bar); } } while (0)

    INR(0) {
        if (bx < 192) {
            const int l = bx / 96, cg = bx % 96;
            LAS float* cact = (LAS float*)lds; LAS float* red = (LAS float*)(lds + 32768);
            for (int i = tid; i < 8 * DM; i += NWAVES * 64) { const float cv = c_in[i]; cact[i] = cv / (1.f + __expf(-cv)); }
            __syncthreads();
            float acc[8];
#pragma unroll
            for (int b = 0; b < 8; ++b) acc[b] = 0.f;
            const float* wp = w_mod + ((size_t)l * DM + wave * 128) * 6144 + 64 * cg + lane;
#pragma unroll 1
            for (int k0 = 0; k0 < 128; k0 += 16) { float wv[16];
#pragma unroll
                for (int k = 0; k < 16; ++k) wv[k] = wp[(size_t)(k0 + k) * 6144];
#pragma unroll
                for (int k = 0; k < 16; ++k)
#pragma unroll
                    for (int b = 0; b < 8; ++b) acc[b] += cact[b * DM + wave * 128 + k0 + k] * wv[k]; }
#pragma unroll
            for (int b = 0; b < 8; ++b) red[(wave * 8 + b) * 64 + lane] = acc[b];
            __syncthreads();
            { const int b = tid >> 6, col = tid & 63; float s = b_mod[l * 6144 + 64 * cg + col];
#pragma unroll
              for (int w = 0; w < 8; ++w) s += red[(w * 8 + b) * 64 + col];
              modv[((size_t)l * 8 + b) * 6144 + 64 * cg + col] = s; }
            __syncthreads();
        }
        {
            pg8::u32x4* z = (pg8::u32x4*)(WIN + (size_t)ZW * DM); const int n16 = (ZP - ZW) * DM * 2 / 16;
            for (int i = bx * 512 + tid; i < n16; i += G * 512) z[i] = (pg8::u32x4){0u, 0u, 0u, 0u};
        }
        LAS float* scr = (LAS float*)(lds + wave * 8448);
        constexpr int I0 = 16 * 21, I1 = 6 * 48, I2 = 4 * 64, I3 = 16 * 32, I4 = 4 * 32;
        constexpr int NITEMS = I0 + I1 + I2 + I3 + I4;
        for (int it = R.gw; it < NITEMS; it += R.ngw) {
            int r = it;
            if (r < I0) { conv_item<4>(w_in, ZW, DM, WIN, nullptr, scr, r / 21, r % 21, lane); continue; } r -= I0;
            if (r < I1) { conv_item<0>(w_uq, NQ, QLR, WUQ, q_norm_g, scr, r / 48, r % 48, lane); continue; } r -= I1;
            if (r < I2) { conv_item<0>(w_ukv, NKV, KVLR, WUKV, kv_norm_g, scr, r / 64, r % 64, lane); continue; } r -= I2;
            if (r < I3) { conv_item<0>(w_o, DM, DM, WO, nullptr, scr, r / 32, r % 32, lane); continue; } r -= I3;
            { const int g = r / 32, q = r % 32; conv_item<0>(w_pool + (size_t)g * 65536, 256, 256, WPOOL + (size_t)g * 65536, nullptr, scr, q / 8, q % 8, lane); }
        }
    }
    SEAM(0);
#define MOE_WEIGHT_FILLER(L, RANK, NIDLE) MOE_WEIGHT_FILLER_R(L, RANK, NIDLE, 0, 3 * 32 * 64)
#define MOE_WEIGHT_FILLER_R(L, RANK, NIDLE, LO, HI) do { LAS float* scr_ = (LAS float*)(lds + wave * 16640); \
        if ((RANK) >= 0) for (int it_ = (LO) + (RANK) * NWAVES + wave; it_ < (HI); it_ += (NIDLE) * NWAVES) { \
            const int kind_ = it_ / 2048, r_ = it_ % 2048, le_ = (L) * 32 + r_ / 64, q2_ = r_ % 64; \
            if (kind_ == 0) conv_item64<2>(w_gate + (size_t)le_ * DM * FF, FF, DM, WGU + (size_t)le_ * 512 * DM, scr_, q2_ / 4, q2_ % 4, lane); \
            else if (kind_ == 1) conv_item64<3>(w_up + (size_t)le_ * DM * FF, FF, DM, WGU + (size_t)le_ * 512 * DM, scr_, q2_ / 4, q2_ % 4, lane); \
            else conv_item64<0>(w_down + (size_t)le_ * FF * DM, DM, FF, WD + (size_t)le_ * DM * FF, scr_, q2_ / 16, q2_ % 16, lane); } } while (0)
    INR(1) rp_h0(R, x, modv0, H0, positions, CS);
    SEAM(1);
    INR(2) { pg8::StaticOrderT<ZP / 256, MK_ZSPLIT != 0> S; S.init(H0, DM, WIN, DM, M, ZP, G, bx); pg8::EpiZ E{Zb, SSQB, KR, CS};
        pg8::gemm_phase<pg8::EpiZ, pg8::StaticOrderT<ZP / 256, MK_ZSPLIT != 0>, true>(lds + RING_OFF, DM, DM, S, E);
        { const int nbusy = (M / 256) * (ZP / 256) - G;
          constexpr int NSPLIT = (3 * 32 * 64 * MK_FILL_PCT / 100) & ~7;
#if MK_FSPLIT
          (void)NSPLIT;
          if (nbusy > 0 && nbusy < G) { if (bx >= nbusy) MOE_WEIGHT_FILLER_R(0, bx - nbusy, G - nbusy, 0, 2 * 32 * 64); } else MOE_WEIGHT_FILLER_R(0, bx, G, 0, 2 * 32 * 64); } }
#else
          if (nbusy > 0 && nbusy < G) { if (bx >= nbusy) MOE_WEIGHT_FILLER_R(0, bx - nbusy, G - nbusy, 0, NSPLIT); else MOE_WEIGHT_FILLER_R(0, bx, nbusy, NSPLIT, 3 * 32 * 64); } else MOE_WEIGHT_FILLER(0, bx, G); } }
#endif
    SEAM(2);
    INR(4) {
#define P4_RS(S, off, n, inv) do { LAS float* rs_ = (LAS float*)(lds + ROWTAB_OFF); pg8::Unit u_; const float* sq_ = SSQB; \
          for (int i_ = 0; i_ < 4; ++i_) { if (!S.next(i_, u_)) break; if (tid < 256) { const float* p_ = sq_ + (size_t)(u_.pm * 256 + tid) * 24 + (off); float s_ = hsum4(*(const f32x4*)p_) + hsum4(*(const f32x4*)(p_ + 4)); if ((n) == 12) s_ += hsum4(*(const f32x4*)(p_ + 8)); \
              rs_[i_ * 256 + tid] = 1.f / sqrtf(s_ * (inv) + RMS_EPS); } } __syncthreads(); } while (0)
#define P4_QG() do { pg8::StaticOrderT<NQ / 256> S; S.init(Zb, ZP, WUQ, QLR, M, NQ, G, bx); P4_RS(S, 0, 12, 1.f / QLR); pg8::EpiStore<false, true> E{Qb, QP, nullptr, 0, QSCALE * F8S, nullptr, nullptr, args.variant, nullptr, 0, 0, 0.f, (const LAS float*)(lds + ROWTAB_OFF)};     \
          pg8::gemm_phase<pg8::EpiStore<false, true>, pg8::StaticOrderT<NQ / 256>, true>(lds + RING_OFF, QLR, QLR, S, E); } while (0)
#define P4_KVG() do { pg8::StaticOrderT<NKV / 256> S; S.init(Zb + QLR, ZP, WUKV, KVLR, M, NKV, G, bx); P4_RS(S, 12, 8, 1.f / KVLR); pg8::EpiStore<false> E{KVB, KVP, nullptr, 0, 1.f, nullptr, nullptr, args.variant, nullptr, 0, 0, 0.f, (const LAS float*)(lds + ROWTAB_OFF)}; \
          pg8::gemm_phase<pg8::EpiStore<false>, pg8::StaticOrderT<NKV / 256>, true>(lds + RING_OFF, KVLR, KVLR, S, E); } while (0)
        if (vcu & 1) { P4_KVG(); P4_QG(); } else { P4_QG(); P4_KVG(); }
#undef P4_QG
#undef P4_RS
#undef P4_KVG
    }
    SEAM(4);
    INR(5) attn::attn_phase<MK_THRL>((char*)lds_dyn + RING_OFF, Qb, KVB, KR, CS, Ob, vcu, G);
    SEAM(5);
    INR(6) { pg8::StaticOrderT<DM / 256> S; S.init(Ob, DM, WO, DM, M, DM, G, bx); pg8::EpiStore<false, YF8> E{Yb, DM, nullptr, 0, YF8 ? F8S : 1.f, nullptr, nullptr};
        pg8::gemm_phase<pg8::EpiStore<false, YF8>, pg8::StaticOrderT<DM / 256>, true>(lds + RING_OFF, DM, DM, S, E); }
    SEAM(6);
#define MOE_LAYER(P, L, RESF32, RES, YBR, XA, XOUT, OUTF32) \
    INR(P) rp_ln1m<RESF32, ((L) == 0 ? YF8 : YPF8)>(lds, L, RES, YBR, modv + (size_t)(L) * 8 * 6 * DM, ln_g + (size_t)(L) * 2 * DM, ln_b + (size_t)(L) * 2 * DM, w_gr, b_gr, w_er, b_er, XA, H2, tok_e, tok_w, tok_t, ctl + CW_CNT + 64 * (L), list, args.variant); \
    SEAM(P); \
    INR((P) + 1) { moe_gemm<true>(lds, L, G, vcu, ctl + CW_CNT + 64 * (L), list, H2, WGU, HE, Y2); { const LAS int* tb_ = (const LAS int*)(lds + TB_OFF); const int nu_ = 2 * tb_[32], tl_ = nu_ % G, nb_ = (MK_MSPLIT && 2 * tl_ <= G) ? 2 * tl_ : tl_;     \
          const int rk_ = nb_ > 0 ? vcu - nb_ : vcu, ni_ = nb_ > 0 ? G - nb_ : G; \
          if (MK_FSPLIT) { if ((L) == 0) { MOE_WEIGHT_FILLER_R(0, rk_, ni_, 2 * 32 * 64, 3 * 32 * 64); MOE_WEIGHT_FILLER_R(1, rk_, ni_, 0, 2 * 32 * 64); }     \
                           else MOE_WEIGHT_FILLER_R(1, rk_, ni_, 2 * 32 * 64, 3 * 32 * 64); }                                                                    \
          else if ((L) == 0) MOE_WEIGHT_FILLER(1, rk_, ni_); } } \
    SEAM((P) + 1); \
    INR((P) + 2) moe_gemm<false>(lds, L, G, vcu, ctl + CW_CNT + 64 * (L), list, HE, WD, HE, Y2, args.variant); \
    SEAM((P) + 2); \
    INR((P) + 3) rp_ln2<OUTF32, true, true>(R, XA, Y2, tok_e, tok_w, tok_t, ctl + CW_CNT + 64 * (L), modv + (size_t)(L) * 8 * 6 * DM, ln_g + (size_t)(L) * 2 * DM + DM, ln_b + (size_t)(L) * 2 * DM + DM, XOUT);
#ifndef MK_FUSE_PG
#define MK_FUSE_PG 1
#endif
#ifndef MK_FUSE_POOL
#define MK_FUSE_POOL 0
#endif
#if MK_FUSE_POOL
    INR(7) rp_ln1m<true, YF8>(lds, 0, x, Yb, modv, ln_g, ln_b, w_gr, b_gr, w_er, b_er, X1, H2, tok_e, tok_w, tok_t, ctl + CW_CNT, list, args.variant);
    SEAM(7);
    INR(8) { moe_gemm<true>(lds, 0, G, vcu, ctl + CW_CNT, list, H2, WGU, HE, Y2); { const LAS int* tb_ = (const LAS int*)(lds + TB_OFF); const int nu_ = 2 * tb_[32], nb_ = nu_ % G;
          if (nb_ > 0) MOE_WEIGHT_FILLER(1, vcu - nb_, G - nb_); else MOE_WEIGHT_FILLER(1, vcu, G); } }
    SEAM(8);
    INR(9) moe_gemm<false>(lds, 0, G, vcu, ctl + CW_CNT, list, HE, WD, HE, Y2, args.variant);
    SEAM(9);
    INR(10) rp_ln2pool(lds, vcu, G, lane, wave, X1, (const unsigned char*)Y2, tok_e, tok_w, tok_t, ctl + CW_CNT, modv, ln_g + DM, ln_b + DM, X2, modv1, MIX);
    SEAM(10);
#else
    MOE_LAYER(7, 0, true, x, Yb, X1, X2, false)
    SEAM(10);
#if MK_FUSE_PG
    INR(11) rp_poolgemm<YPF8>(lds, vcu, G, X2, modv1, WPOOL, pool_scale, YP);
#else
    INR(11) rp_pool(R, X2, modv1, MIX);
    SEAM(11);
#endif
#endif
#if !MK_FUSE_PG
    INR(12) { pg8::BlockDiagOrder S; S.init(MIX, DM, WPOOL, M, G, bx); pg8::EpiStore<false, YPF8> E{YP, DM, nullptr, 0, YPF8 ? F8S : 1.f, pool_scale, nullptr};
        pg8::gemm_phase<pg8::EpiStore<false, YPF8>, pg8::BlockDiagOrder, true>(lds + RING_OFF, 256, 256, S, E); }
#endif
#if MK_FUSE_PG
    if (IN(11) && IN(13)) { asm volatile("s_waitcnt vmcnt(0)" ::: "memory"); __syncthreads(); }
#else
    SEAM(12);
#endif
    MOE_LAYER(13, 1, false, X2, YP, X3, OUTPTR, true)
#undef IN
#undef SEAM
#undef SSQB
#undef x
#undef c_in
#undef positions
#undef w_mod
#undef b_mod
#undef ln_g
#undef ln_b
#undef w_in
#undef q_norm_g
#undef kv_norm_g
#undef w_uq
#undef w_ukv
#undef w_o
#undef w_pool
#undef pool_scale
#undef w_gr
#undef b_gr
#undef w_er
#undef b_er
#undef w_gate
#undef w_up
#undef w_down
#undef OUTPTR
#undef ctl
#undef modv
#undef modv0
#undef modv1
#undef WGU
#undef WD
#undef WIN
#undef WUQ
#undef WUKV
#undef WO
#undef WPOOL
#undef tok_e
#undef tok_w
#undef tok_t
#undef rstd
#undef X1
#undef H2
#undef KVB
#undef Qb
#undef HE
#undef X2
#undef Ob
#undef Y2
#undef Zb
#undef Yb
#undef H0
#undef KR
#undef list
#undef CS
#undef MIX
#undef YP
#undef X3
#undef KA_
#undef ARGQ
#undef INP
#undef WSB
}
#ifndef MK_ONE_LAUNCH
#define MK_ONE_LAUNCH 0
#endif
#ifndef MK_FASTMASK
#define MK_FASTMASK 0x1FFFF
#endif
extern "C" void kernel_launch(void* const* d_in, const int* in_sizes, int n_in, void* d_out, int out_size, void* d_ws, size_t ws_size, hipStream_t stream) {
    static int grid = 0;
    if (grid == 0) {
        if (n_in != 22 || in_sizes[0] != M * DM || out_size != M * DM || ws_size < WS_END) { fprintf(stderr, "kernel_launch: unexpected sizes n_in %d in0 %d out %d ws %zu\n", n_in, n_in > 0 ? in_sizes[0] : -1, out_size, ws_size); grid = -1; return; }
        (void)hipFuncSetAttribute((const void*)rk_ln1<true, false>, hipFuncAttributeMaxDynamicSharedMemorySize, LN1_LDS_BYTES);
        (void)hipFuncSetAttribute((const void*)rk_ln1<false, false>, hipFuncAttributeMaxDynamicSharedMemorySize, LN1_LDS_BYTES);
        if (hipFuncSetAttribute((const void*)mk_fwd, hipFuncAttributeMaxDynamicSharedMemorySize, LDS_BYTES) != hipSuccess) { fprintf(stderr, "kernel_launch: hipFuncSetAttribute(mk_fwd, %d) failed\n", LDS_BYTES); grid = -1; return; }
        int dev = 0, cus = 0, per_cu = 0;
        if (hipGetDevice(&dev) != hipSuccess || hipDeviceGetAttribute(&cus, hipDeviceAttributeMultiprocessorCount, dev) != hipSuccess) { grid = -1; return; }
        if (hipOccupancyMaxActiveBlocksPerMultiprocessor(&per_cu, (const void*)mk_fwd, NWAVES * 64, LDS_BYTES) != hipSuccess || per_cu < 1) fprintf(stderr, "kernel_launch: occupancy query reports %d\n", per_cu);
        (void)hipGetLastError();
        grid = cus;
        if (grid != 256) fprintf(stderr, "kernel_launch: %d CUs (built for 256)\n", grid);
    }
    if (grid < 0) return;
    const float* x = (const float*)d_in[0]; const float* c = (const float*)d_in[1]; const int* positions = (const int*)d_in[2];
    const float* w_mod = (const float*)d_in[3]; const float* b_mod = (const float*)d_in[4]; const float* ln_g = (const float*)d_in[5]; const float* ln_b = (const float*)d_in[6];
    const float* w_in = (const float*)d_in[7]; const float* q_norm_g = (const float*)d_in[8]; const float* kv_norm_g = (const float*)d_in[9];
    const float* w_uq = (const float*)d_in[10]; const float* w_ukv = (const float*)d_in[11]; const float* w_o = (const float*)d_in[12];
    const float* w_pool = (const float*)d_in[13]; const float* pool_scale = (const float*)d_in[14];
    const float* w_gr = (const float*)d_in[15]; const float* b_gr = (const float*)d_in[16]; const float* w_er = (const float*)d_in[17]; const float* b_er = (const float*)d_in[18];
    const float* w_gate = (const float*)d_in[19]; const float* w_up = (const float*)d_in[20]; const float* w_down = (const float*)d_in[21];
    unsigned char* ws = (unsigned char*)d_ws;
    unsigned* ctl = (unsigned*)(ws + WS_CTL); float* modv = (float*)(ws + WS_MODV);
    int* tok_e = (int*)(ws + WS_TOK); float* tok_w = (float*)(ws + WS_TOK + 256 * 1024); int* tok_t = (int*)(ws + WS_TOK + 512 * 1024);
    float* rstd = (float*)(ws + WS_RSTD); bf16_t* X1 = (bf16_t*)(ws + WS_X1); bf16_t* H2 = (bf16_t*)(ws + WS_H2); bf16_t* KVB = (bf16_t*)(ws + WS_KVB); bf16_t* Qb = (bf16_t*)(ws + WS_Q);
    bf16_t* X2 = (bf16_t*)(ws + WS_X2); bf16_t* Ob = (bf16_t*)(ws + WS_O); bf16_t* Y2 = (bf16_t*)(ws + WS_Y2); bf16_t* Zb = (bf16_t*)(ws + WS_Z); bf16_t* Yb = (bf16_t*)(ws + WS_Y);
    bf16_t* H0 = (bf16_t*)(ws + WS_H0); bf16_t* KR = (bf16_t*)(ws + WS_KR); int* list = (int*)(ws + WS_LIST);
    (void)hipMemsetAsync(ws + WS_CTL, 0, CTL_ZERO_BYTES, stream);
    const float* modv0 = modv; const float* modv1 = modv + 8 * 6 * DM;
    bf16_t* MIX = H2; bf16_t* YP = Y2; bf16_t* X3 = X1;
    Args a{};
    for (int i = 0; i < 22; ++i) a.in[i] = d_in[i];
    a.out = (float*)d_out; a.ws = ws;
    if (MK_ONE_LAUNCH) { a.ph_lo = 0; a.ph_hi = NPHASE; hipLaunchKernelGGL(mk_fwd, dim3(grid), dim3(NWAVES * 64), LDS_BYTES, stream, a); return; }
    const unsigned fm = MK_FASTMASK;
#define FAST(k) ((fm >> (k)) & 1u)
#ifndef MK_VARIANT
#define MK_VARIANT 0
#endif
#ifndef MK_HDBL
#define MK_HDBL 0
#endif
#define RUNF(k) do { a.ph_lo = (k); a.ph_hi = (k) + 1; for (int rep_ = 0; rep_ < ((((MK_HDBL) >> (k)) & 1) ? 2 : 1); ++rep_) { a.variant = rep_ ? MK_VARIANT : 0; hipLaunchKernelGGL(mk_fwd, dim3(grid), dim3(NWAVES * 64), LDS_BYTES, stream, a); } a.variant = 0; } while (0)
    if (FAST(0)) RUNF(0); else nk_mod<<<2 * 8 * 6144 / 256, 256, 0, stream>>>(c, w_mod, b_mod, modv);
    if (FAST(1)) RUNF(1); else rk_h0<<<256, 512, 0, stream>>>(x, modv0, H0);
    if (FAST(2)) RUNF(2); else nk_gemm<EpiPlain><<<dim3(3, M / 8), 256, 0, stream>>>(H0, DM, w_in, ZW, nullptr, DM, ZW, mk_epi(Zb, ZP, nullptr, 0, 1.f, nullptr));
    if (FAST(3)) RUNF(3); else rk_rms<<<256, 512, 0, stream>>>(Zb, positions, rstd, KR, (float*)(ws + WS_CS));
    if (FAST(4)) { RUNF(4); if (!FAST(5)) nk_rope_q<<<M * 256 / 256, 256, 0, stream>>>(Qb, positions); } else {
        nk_gemm<EpiPlain><<<dim3(6, M / 8), 256, 0, stream>>>(Zb, ZP, w_uq, NQ, q_norm_g, QLR, NQ, mk_epi(Qb, QP, rstd, 2, QSCALE, nullptr));
        if (!FAST(5)) nk_rope_q<<<M * 256 / 256, 256, 0, stream>>>(Qb, positions);
        nk_gemm<EpiPlain><<<dim3(8, M / 8), 256, 0, stream>>>(Zb + QLR, ZP, w_ukv, NKV, kv_norm_g, KVLR, NKV, mk_epi(KVB, KVP, rstd + 1, 2, 1.f, nullptr)); }
    if (FAST(5)) RUNF(5); else nk_attn<<<dim3(SEQ / 64, NH, BATCH), 64, 0, stream>>>(Qb, KVB, KR, Ob);
    if (FAST(6)) RUNF(6); else nk_gemm<EpiPlain><<<dim3(4, M / 8), 256, 0, stream>>>(Ob, DM, w_o, DM, nullptr, DM, DM, mk_epi(Yb, DM, nullptr, 0, 1.f, nullptr));
    if (FAST(7)) { RUNF(7); RUNF(8); RUNF(9); RUNF(10); } else {
        rk_ln1<true, false><<<256, 512, LN1_LDS_BYTES, stream>>>(0, x, Yb, modv0, ln_g, ln_b, w_gr, b_gr, w_er, b_er, X1, H2, tok_e, tok_w, tok_t, ctl + CW_CNT, list);
        nk_moe<<<2 * M, 256, 0, stream>>>(H2, tok_e, w_gate, w_up, w_down, Y2);
        rk_ln2<false, false><<<256, 512, 0, stream>>>(X1, Y2, tok_e, tok_w, tok_t, ctl + CW_CNT, modv0, ln_g + DM, ln_b + DM, X2); }
    if (FAST(11)) RUNF(11); else rk_pool<<<256, 512, 0, stream>>>(X2, modv1, MIX);
    if (FAST(12)) RUNF(12); else for (int g = 0; g < 4; ++g)
        nk_gemm<EpiPlain><<<dim3(1, M / 8), 256, 0, stream>>>(MIX + g * 256, DM, w_pool + (size_t)g * 256 * 256, 256, nullptr, 256, 256, mk_epi(YP + g * 256, DM, nullptr, 0, 1.f, pool_scale + g * 256));
    if (FAST(13)) { RUNF(13); RUNF(14); RUNF(15); RUNF(16); } else {
        rk_ln1<false, false><<<256, 512, LN1_LDS_BYTES, stream>>>(1, X2, YP, modv1, ln_g + 2 * DM, ln_b + 2 * DM, w_gr, b_gr, w_er, b_er, X3, H2, tok_e, tok_w, tok_t, ctl + CW_CNT + 64, list);
        nk_moe<<<2 * M, 256, 0, stream>>>(H2, tok_e, w_gate + (size_t)NE * DM * FF, w_up + (size_t)NE * DM * FF, w_down + (size_t)NE * FF * DM, Y2);
        rk_ln2<true, false><<<256, 512, 0, stream>>>(X3, Y2, tok_e, tok_w, tok_t, ctl + CW_CNT + 64, modv1, ln_g + 3 * DM, ln_b + 3 * DM, d_out); }
}
```
